# Optimizing an MI355X kernel written in HIP

```python
import math
import jax, jax.numpy as jnp
from jax import lax
import numpy as np

D_MODEL = 1024
BATCH = 8
SEQ = 2048
DEPTH = 4

EXPAND = 2
E_WIDTH = EXPAND * D_MODEL
HEAD_DIM = 128
SB_HEADS = E_WIDTH // HEAD_DIM
DF_HEADS = E_WIDTH // (2 * HEAD_DIM)
Q_BLOCK = 128
ROPE_THETA = 10000.0
EPS = 1e-6
N_MIXERS = 2
N_SB = (DEPTH + 1) // 2
N_DF = DEPTH // 2

kernel_name = "hybrid_stickbreak_diffattn_gated"


def rms_norm(x, g):
    xf = x.astype(jnp.float32)
    y = xf * lax.rsqrt(jnp.mean(xf * xf, axis=-1, keepdims=True) + EPS)
    return (y * g.astype(jnp.float32)).astype(x.dtype)


def rope_tables(seq, dim):
    inv = 1.0 / (ROPE_THETA ** (jnp.arange(0, dim, 2, dtype=jnp.float32) / dim))
    ang = jnp.arange(seq, dtype=jnp.float32)[:, None] * inv[None, :]
    return jnp.cos(ang), jnp.sin(ang)


def apply_rope(x, cos, sin):
    xf = x.astype(jnp.float32)
    half = xf.shape[-1] // 2
    x1, x2 = xf[..., :half], xf[..., half:]
    out = jnp.concatenate([x1 * cos - x2 * sin, x2 * cos + x1 * sin], axis=-1)
    return out.astype(x.dtype)


def stick_breaking_attention(q, k, v):
    S = q.shape[2]
    scale = 1.0 / math.sqrt(q.shape[-1])
    outs = []
    for t0 in range(0, S, Q_BLOCK):
        t1 = t0 + Q_BLOCK
        z = jnp.einsum('bhqd,bhkd->bhqk', q[:, :, t0:t1], k[:, :, :t1]).astype(jnp.float32) * scale
        t_idx = t0 + jnp.arange(Q_BLOCK)[:, None]
        s_idx = jnp.arange(t1)[None, :]
        mask = s_idx < t_idx
        log_beta = jax.nn.log_sigmoid(z)
        log_1m = jnp.where(mask, jax.nn.log_sigmoid(-z), 0.0)
        suffix = lax.cumsum(log_1m, axis=3, reverse=True) - log_1m
        attn = jnp.where(mask, jnp.exp(log_beta + suffix), 0.0)
        outs.append(jnp.einsum('bhqk,bhkd->bhqd', attn.astype(v.dtype), v[:, :, :t1]))
    return jnp.concatenate(outs, axis=2)


def differential_attention(q, k, v, lam):
    S = q.shape[3]
    scale = 1.0 / math.sqrt(q.shape[-1])
    outs = []
    for t0 in range(0, S, Q_BLOCK):
        t1 = t0 + Q_BLOCK
        z = jnp.einsum('bhmqd,bhmkd->bhmqk', q[:, :, :, t0:t1], k[:, :, :, :t1]).astype(jnp.float32) * scale
        t_idx = t0 + jnp.arange(Q_BLOCK)[:, None]
        s_idx = jnp.arange(t1)[None, :]
        z = jnp.where(s_idx <= t_idx, z, -jnp.inf)
        p = jax.nn.softmax(z, axis=-1)
        a = p[:, :, 0] - lam * p[:, :, 1]
        outs.append(jnp.einsum('bhqk,bhkd->bhqd', a.astype(v.dtype), v[:, :, :t1]))
    return jnp.concatenate(outs, axis=2)


def setup_inputs(seed: int = 0) -> dict:
    key = jax.random.key(seed)
    ks = jax.random.split(key, 16)
    f32 = jnp.float32
    x = jax.random.normal(ks[0], (BATCH, SEQ, D_MODEL), f32)
    sb_norm = 1.0 + 0.02 * jax.random.normal(ks[1], (N_SB, D_MODEL), f32)
    sb_w_in = jax.random.normal(ks[2], (N_SB, D_MODEL, 4 * E_WIDTH), f32) * D_MODEL ** -0.5
    sb_w_out = jax.random.normal(ks[3], (N_SB, E_WIDTH, D_MODEL), f32) * E_WIDTH ** -0.5
    df_norm = 1.0 + 0.02 * jax.random.normal(ks[4], (N_DF, D_MODEL), f32)
    df_w_in = jax.random.normal(ks[5], (N_DF, D_MODEL, 4 * E_WIDTH), f32) * D_MODEL ** -0.5
    df_w_out = jax.random.normal(ks[6], (N_DF, E_WIDTH, D_MODEL), f32) * E_WIDTH ** -0.5
    df_q_norm = 1.0 + 0.02 * jax.random.normal(ks[7], (N_DF, HEAD_DIM), f32)
    df_k_norm = 1.0 + 0.02 * jax.random.normal(ks[8], (N_DF, HEAD_DIM), f32)
    df_lam_q1 = 0.1 * jax.random.normal(ks[9], (N_DF, HEAD_DIM), f32)
    df_lam_k1 = 0.1 * jax.random.normal(ks[10], (N_DF, HEAD_DIM), f32)
    df_lam_q2 = 0.1 * jax.random.normal(ks[11], (N_DF, HEAD_DIM), f32)
    df_lam_k2 = 0.1 * jax.random.normal(ks[12], (N_DF, HEAD_DIM), f32)
    df_sub_norm = 1.0 + 0.02 * jax.random.normal(ks[13], (N_DF, 2 * HEAD_DIM), f32)
    return {"x": x, "sb_norm": sb_norm, "sb_w_in": sb_w_in, "sb_w_out": sb_w_out,
            "df_norm": df_norm, "df_w_in": df_w_in, "df_w_out": df_w_out,
            "df_q_norm": df_q_norm, "df_k_norm": df_k_norm,
            "df_lam_q1": df_lam_q1, "df_lam_k1": df_lam_k1,
            "df_lam_q2": df_lam_q2, "df_lam_k2": df_lam_k2,
            "df_sub_norm": df_sub_norm}


def reference(x, sb_norm, sb_w_in, sb_w_out, df_norm, df_w_in, df_w_out,
              df_q_norm, df_k_norm, df_lam_q1, df_lam_k1, df_lam_q2, df_lam_k2,
              df_sub_norm):
    B, S, _ = x.shape
    cos, sin = rope_tables(S, HEAD_DIM)
    h = x
    for i in range(DEPTH):
        j = i // N_MIXERS
        if i % N_MIXERS == 0:
            u = rms_norm(h, sb_norm[j])
            proj = jnp.einsum('bsd,de->bse', u, sb_w_in[j])
            q, k, v, z = jnp.split(proj, 4, axis=-1)
            to_heads = lambda t: t.reshape(B, S, SB_HEADS, HEAD_DIM).transpose(0, 2, 1, 3)
            o = stick_breaking_attention(to_heads(q), to_heads(k), to_heads(v))
            o = o.transpose(0, 2, 1, 3).reshape(B, S, E_WIDTH)
            y = o * jax.nn.silu(z)
            h = h + jnp.einsum('bse,ed->bsd', y, sb_w_out[j])
        else:
            lam_init = 0.8 - 0.6 * math.exp(-0.3 * i)
            u = rms_norm(h, df_norm[j])
            proj = jnp.einsum('bsd,de->bse', u, df_w_in[j])
            q, k, v, z = jnp.split(proj, 4, axis=-1)
            q = q.reshape(B, S, DF_HEADS, 2, HEAD_DIM).transpose(0, 2, 3, 1, 4)
            k = k.reshape(B, S, DF_HEADS, 2, HEAD_DIM).transpose(0, 2, 3, 1, 4)
            v = v.reshape(B, S, DF_HEADS, 2 * HEAD_DIM).transpose(0, 2, 1, 3)
            q = apply_rope(rms_norm(q, df_q_norm[j]), cos, sin)
            k = apply_rope(rms_norm(k, df_k_norm[j]), cos, sin)
            lam = (jnp.exp(jnp.sum(df_lam_q1[j].astype(jnp.float32) * df_lam_k1[j].astype(jnp.float32)))
                   - jnp.exp(jnp.sum(df_lam_q2[j].astype(jnp.float32) * df_lam_k2[j].astype(jnp.float32)))
                   + lam_init)
            o = differential_attention(q, k, v, lam)
            o = rms_norm(o, df_sub_norm[j]) * (1.0 - lam_init)
            o = o.transpose(0, 2, 1, 3).reshape(B, S, E_WIDTH)
            y = o * jax.nn.silu(z)
            h = h + jnp.einsum('bse,ed->bsd', y, df_w_out[j])
    return h
```

```cpp
#include <hip/hip_runtime.h>
#include <hip/hip_cooperative_groups.h>
#include <cstdio>
#include <cstdint>
namespace cg = cooperative_groups;
__device__ __forceinline__ int my_tid(int wave0) { int l; asm volatile("v_mbcnt_lo_u32_b32 %0, -1, 0\n\tv_mbcnt_hi_u32_b32 %0, -1, %0" : "=&v"(l)); return wave0 * 64 + l; }
template <int MASK> __device__ __forceinline__ float xshfl(float v) {
    if constexpr (MASK == 32) { auto rr = __builtin_amdgcn_permlane32_swap(__float_as_uint(v), __float_as_uint(v), false, false); int l; asm volatile("v_mbcnt_lo_u32_b32 %0, -1, 0" : "=v"(l)); (void)l;
        return __uint_as_float(rr[0]) == v ? __uint_as_float(rr[1]) : __uint_as_float(rr[0]); }
    else return __int_as_float(__builtin_amdgcn_ds_swizzle(__float_as_int(v), (MASK << 10) | 0x1F));
}
template <int MASK> __device__ __forceinline__ float xsum(float v) {
    if constexpr (MASK == 32) { auto rr = __builtin_amdgcn_permlane32_swap(__float_as_uint(v), __float_as_uint(v), false, false); return __uint_as_float(rr[0]) + __uint_as_float(rr[1]); }
    else return v + __int_as_float(__builtin_amdgcn_ds_swizzle(__float_as_int(v), (MASK << 10) | 0x1F));
}
#define PROBE 0
namespace pg8 {
#define PG8_LAS __attribute__((address_space(3)))
typedef unsigned short bf16_t;
typedef short bf16x8 __attribute__((ext_vector_type(8)));
typedef float f32x4 __attribute__((ext_vector_type(4)));
typedef unsigned u32x4 __attribute__((ext_vector_type(4)));
constexpr int BM = 256, BK = 64, HALF = 128, HTB = HALF * BK * 2  , STAGE_BYTES = 8 * HTB, NXCD = 8, WGM = 8;

__host__ __device__ __forceinline__ int lds_byte(int r, int c) { const int st = (r >> 4) * 2 + (c >> 5), rr = r & 15, cc = c & 31, ob = rr * 64 + cc * 2; return st * 1024 + (ob ^ (((ob >> 9) & 1) << 5)); }
__host__ __device__ __forceinline__ void stage_rc(int b, int& R, int& C) { const int st = b / 1024, sb = b % 1024, swz = sb ^ (((sb >> 9) & 1) << 5); R = (st >> 1) * 16 + swz / 64; C = (st & 1) * 32 + (swz % 64) / 2; }
__host__ __device__ __forceinline__ int perm32(int rho) { const int n = rho >> 4, i = rho & 15; return 8 * (i >> 2) + 4 * n + (i & 3); }

struct Unit { int pm, pn; };
struct Gemm { const bf16_t* A; const bf16_t* Bt; int M, N, K, lda, wave; };

struct StaticOrder {
    int nM, nN, nwg, G, c;
    __host__ __device__ void init(int M, int N, int G_, int c_) { nM = M / BM; nN = N / BM; nwg = nM * nN; G = G_; c = c_; }
    __host__ __device__ bool next(int i, Unit& u) const {
        const long L = (long)i * G + c; if (L >= nwg) return false;
        int wgid = (int)L; { const int q = nwg / NXCD, r = nwg % NXCD, xcd = wgid % NXCD, off = wgid / NXCD; wgid = (xcd < r ? xcd * (q + 1) : r * (q + 1) + (xcd - r) * q) + off; }
        const int nig = WGM * nN, gid = wgid / nig, fm = gid * WGM, gsz = (nM - fm) < WGM ? (nM - fm) : WGM;
        u.pm = fm + ((wgid % nig) % gsz); u.pn = (wgid % nig) / gsz; return true;
    }
    __device__ __forceinline__ void a_ready(const Unit&) const {}
    __device__ __forceinline__ void done(const Unit&) const {}
};

__device__ __forceinline__ unsigned cvt_pk_bf16(float lo, float hi) { unsigned r; asm volatile("v_cvt_pk_bf16_f32 %0, %1, %2" : "=v"(r) : "v"(lo), "v"(hi)); return r; }
struct EpiStoreBf16 {
    static constexpr bool PERM = true, AFTER_DRAIN = false;
    bf16_t* O; int ldc; int rope; PG8_LAS float* xl;
    __device__ __forceinline__ void operator()(const f32x4 (&acc)[2][2][4][2], const Unit& u, int wr, int wc, int fr, int fq) const {
        const int row0 = u.pm * BM + wr * 64 + fr;
        if (rope && u.pn < 16) {
#pragma unroll
            for (int ai = 0; ai < 2; ++ai)
#pragma unroll
                for (int m = 0; m < 4; ++m) { float s = 0.f;
#pragma unroll
                    for (int bj = 0; bj < 2; ++bj)
#pragma unroll
                        for (int n = 0; n < 2; ++n) { const f32x4 x = acc[ai][bj][m][n]; s += (x[0] * x[0] + x[1] * x[1]) + (x[2] * x[2] + x[3] * x[3]); }
                    s = xsum<16>(s); s = xsum<32>(s);
                    if (fq == 0) xl[(ai * HALF + wr * 64 + m * 16 + fr) * 4 + wc] = s; }
            asm volatile("s_waitcnt lgkmcnt(0)" ::: "memory"); __builtin_amdgcn_s_barrier(); asm volatile("" ::: "memory");
            const int i0 = 32 * (wc & 1) + 8 * fq;
            const PG8_LAS float* gt = xl + 1024 + (u.pn >= 8 ? 128 : 0);
            const int colo = u.pn * BM + (wc >> 1) * 128 + i0;
#pragma unroll
            for (int ai = 0; ai < 2; ++ai)
#pragma unroll
                for (int m = 0; m < 4; ++m) { const int rloc = ai * HALF + wr * 64 + m * 16 + fr, row = u.pm * BM + rloc;
                    asm volatile("" ::: "memory");
                    int i0o = i0; asm volatile("" : "+v"(i0o));
                    const float rstd = __builtin_amdgcn_rsqf((xl[rloc * 4 + wc] + xl[rloc * 4 + (wc ^ 1)]) * (1.0f / 128.0f) + 1e-6f);
                    const float pos = (float)(row & 2047);
                    u32x4 w1, w2;
#pragma unroll
                    for (int n = 0; n < 2; ++n) { const f32x4 g1 = *(const PG8_LAS f32x4*)(gt + i0o + 4 * n), g2 = *(const PG8_LAS f32x4*)(gt + 64 + i0o + 4 * n);
                        float o1[4], o2[4];
#pragma unroll
                        for (int jj = 0; jj < 4; ++jj) { const float fr_ = __builtin_amdgcn_exp2f(-(float)(i0o + 4 * n + jj) * (13.287712379549449f / 64.0f)) * 0.15915494309189535f;
                            float r = pos * fr_; r -= __builtin_floorf(r); const float c = __builtin_amdgcn_cosf(r), sn = __builtin_amdgcn_sinf(r);
                            const float n1 = acc[ai][0][m][n][jj] * rstd * g1[jj], n2 = acc[ai][1][m][n][jj] * rstd * g2[jj];
                            o1[jj] = n1 * c - n2 * sn; o2[jj] = n2 * c + n1 * sn; }
                        if (n == 0) { w1.x = cvt_pk_bf16(o1[0], o1[1]); w1.y = cvt_pk_bf16(o1[2], o1[3]); w2.x = cvt_pk_bf16(o2[0], o2[1]); w2.y = cvt_pk_bf16(o2[2], o2[3]); }
                        else { w1.z = cvt_pk_bf16(o1[0], o1[1]); w1.w = cvt_pk_bf16(o1[2], o1[3]); w2.z = cvt_pk_bf16(o2[0], o2[1]); w2.w = cvt_pk_bf16(o2[2], o2[3]); } }
                    bf16_t* rowp = O + (size_t)row * ldc + colo;
                    *(u32x4*)rowp = w1; *(u32x4*)(rowp + 64) = w2; }
            return;
        }
        const int col0 = u.pn * BM + wc * 32 + 8 * fq;
#pragma unroll
        for (int ai = 0; ai < 2; ++ai)
#pragma unroll
            for (int m = 0; m < 4; ++m) { bf16_t* rowp = O + (size_t)(row0 + ai * HALF + m * 16) * ldc + col0;
#pragma unroll
                for (int bj = 0; bj < 2; ++bj) { const f32x4 v0 = acc[ai][bj][m][0], v1 = acc[ai][bj][m][1];
                    u32x4 w; w.x = cvt_pk_bf16(v0[0], v0[1]); w.y = cvt_pk_bf16(v0[2], v0[3]); w.z = cvt_pk_bf16(v1[0], v1[1]); w.w = cvt_pk_bf16(v1[2], v1[3]);
                    *(u32x4*)(rowp + bj * HALF) = w; } }
    }
};
__device__ __forceinline__ float silu_f(float z) { return z * __builtin_amdgcn_rcpf(1.0f + __builtin_amdgcn_exp2f(-1.4426950408889634f * z)); }
struct EpiGate {
    static constexpr bool PERM = true, AFTER_DRAIN = false;
    bf16_t* Y; int ldc;
    __device__ __forceinline__ void operator()(const f32x4 (&acc)[2][2][4][2], const Unit& u, int wr, int wc, int fr, int fq) const {
        const int row0 = u.pm * BM + wr * 64 + fr; const int col0 = u.pn * BM + wc * 32 + 8 * fq;
#pragma unroll
        for (int ai = 0; ai < 2; ++ai)
#pragma unroll
            for (int m = 0; m < 4; ++m) { bf16_t* rowp = Y + (size_t)(row0 + ai * HALF + m * 16) * ldc + col0;
#pragma unroll
                for (int bj = 0; bj < 2; ++bj) { const f32x4 v0 = acc[ai][bj][m][0], v1 = acc[ai][bj][m][1];
                    const u32x4 o = *(const u32x4*)(rowp + bj * HALF);
                    u32x4 w;
                    w.x = cvt_pk_bf16(__uint_as_float(o.x << 16) * silu_f(v0[0]), __uint_as_float(o.x & 0xffff0000u) * silu_f(v0[1]));
                    w.y = cvt_pk_bf16(__uint_as_float(o.y << 16) * silu_f(v0[2]), __uint_as_float(o.y & 0xffff0000u) * silu_f(v0[3]));
                    w.z = cvt_pk_bf16(__uint_as_float(o.z << 16) * silu_f(v1[0]), __uint_as_float(o.z & 0xffff0000u) * silu_f(v1[1]));
                    w.w = cvt_pk_bf16(__uint_as_float(o.w << 16) * silu_f(v1[2]), __uint_as_float(o.w & 0xffff0000u) * silu_f(v1[3]));
                    *(u32x4*)(rowp + bj * HALF) = w; } }
    }
};
struct EpiResidual {
    static constexpr bool PERM = false, AFTER_DRAIN = false;
    const float* base; float* out; int ldc;
    __device__ __forceinline__ void operator()(const f32x4 (&acc)[2][2][4][2], const Unit& u, int wr, int wc, int fr, int fq) const {
        const int row0 = u.pm * BM + wr * 64 + fr; const int col0 = u.pn * BM + wc * 32 + 4 * fq;
#pragma unroll
        for (int ai = 0; ai < 2; ++ai)
#pragma unroll
            for (int m = 0; m < 4; ++m) { const size_t off = (size_t)(row0 + ai * HALF + m * 16) * ldc + col0;
#pragma unroll
                for (int bj = 0; bj < 2; ++bj)
#pragma unroll
                    for (int n = 0; n < 2; ++n) { const f32x4 b = *(const f32x4*)(base + off + bj * HALF + n * 16);
                        *(f32x4*)(out + off + bj * HALF + n * 16) = b + acc[ai][bj][m][n]; } }
    }
};

struct RowStats {
    unsigned* xbuf;
    unsigned* cnt;
    __device__ __forceinline__ void run(const f32x4 (&v)[2][2][4][2], const Unit& u, int wr, int wc, int fr, int fq, PG8_LAS unsigned char* lds, int wid, int lane) const {
        PG8_LAS float* P = (PG8_LAS float*)lds;
        PG8_LAS float* S = (PG8_LAS float*)(lds + 8192);
#pragma unroll
        for (int ai = 0; ai < 2; ++ai)
#pragma unroll
            for (int m = 0; m < 4; ++m) { float s = 0.f;
#pragma unroll
                for (int bj = 0; bj < 2; ++bj)
#pragma unroll
                    for (int n = 0; n < 2; ++n) { const f32x4 x = v[ai][bj][m][n]; s += (x[0] * x[0] + x[1] * x[1]) + (x[2] * x[2] + x[3] * x[3]); }
                s = xsum<16>(s); s = xsum<32>(s);
                if (fq == 0) P[(ai * HALF + wr * 64 + m * 16 + fr) * 4 + wc] = s; }
        asm volatile("s_waitcnt lgkmcnt(0)" ::: "memory"); __builtin_amdgcn_s_barrier(); asm volatile("" ::: "memory");
        const int row = wid * 32 + (lane & 31);
        if (lane < 32) { const float s = (P[row * 4 + 0] + P[row * 4 + 1]) + (P[row * 4 + 2] + P[row * 4 + 3]);
            __hip_atomic_store(xbuf + (size_t)(u.pm * BM + row) * 4 + u.pn, __float_as_uint(s), __ATOMIC_RELAXED, __HIP_MEMORY_SCOPE_AGENT); }
        asm volatile("s_waitcnt vmcnt(0)" ::: "memory");
        if (lane == 0) __hip_atomic_fetch_add(cnt + 64 * u.pm, 1u, __ATOMIC_RELAXED, __HIP_MEMORY_SCOPE_AGENT);
        if (wid == 0) {
            unsigned spins = 0;
            while ((unsigned)__builtin_amdgcn_readfirstlane(__hip_atomic_load(cnt + 64 * u.pm, __ATOMIC_RELAXED, __HIP_MEMORY_SCOPE_AGENT)) < 32u) { __builtin_amdgcn_s_sleep(2); if (++spins > (1u << 22)) break; }
            __builtin_amdgcn_fence(__ATOMIC_ACQUIRE, "agent");
        }
        asm volatile("s_waitcnt vmcnt(0) lgkmcnt(0)" ::: "memory"); __builtin_amdgcn_s_barrier(); asm volatile("" ::: "memory");
        if (lane < 32) { unsigned* slot = xbuf + (size_t)(u.pm * BM + row) * 4; float s[4];
#pragma unroll
            for (int t = 0; t < 4; ++t) s[t] = __uint_as_float(__hip_atomic_load(slot + t, __ATOMIC_RELAXED, __HIP_MEMORY_SCOPE_AGENT));
            S[row] = __builtin_amdgcn_rsqf(((s[0] + s[1]) + (s[2] + s[3])) * (1.0f / 1024.0f) + 1e-6f); }
        asm volatile("s_waitcnt lgkmcnt(0)" ::: "memory"); __builtin_amdgcn_s_barrier(); asm volatile("" ::: "memory");
    }
};
struct EpiResNorm {
    static constexpr bool PERM = false, AFTER_DRAIN = true;
    const float* base; float* out; int ldc; bf16_t* xn; const float* g; RowStats st;
    __device__ __forceinline__ void operator()(const f32x4 (&)[2][2][4][2], const Unit&, int, int, int, int) const {}
    __device__ __forceinline__ void fused(f32x4 (&acc)[2][2][4][2], const Unit& u, int wr, int wc, int fr, int fq, PG8_LAS unsigned char* lds, int wid, int lane) const {
        typedef unsigned u32x2v __attribute__((ext_vector_type(2)));
        const PG8_LAS float* S = (const PG8_LAS float*)(lds + 8192);
        const int col0 = u.pn * BM + wc * 32 + 4 * fq;
#pragma unroll
        for (int ai = 0; ai < 2; ++ai)
#pragma unroll
            for (int m = 0; m < 4; ++m) { const size_t off = (size_t)(u.pm * BM + ai * HALF + wr * 64 + m * 16 + fr) * ldc + col0;
#pragma unroll
                for (int bj = 0; bj < 2; ++bj)
#pragma unroll
                    for (int n = 0; n < 2; ++n) acc[ai][bj][m][n] += *(const f32x4*)(base + off + bj * HALF + n * 16);
                asm volatile("" : "+v"(acc[ai][0][m][0]), "+v"(acc[ai][0][m][1]), "+v"(acc[ai][1][m][0]), "+v"(acc[ai][1][m][1]));
                if (m & 1) asm volatile("" ::: "memory"); }
        st.run(acc, u, wr, wc, fr, fq, lds, wid, lane);
        f32x4 gv[2][2];
#pragma unroll
        for (int bj = 0; bj < 2; ++bj)
#pragma unroll
            for (int n = 0; n < 2; ++n) gv[bj][n] = *(const f32x4*)(g + col0 + bj * HALF + n * 16);
#pragma unroll
        for (int ai = 0; ai < 2; ++ai)
#pragma unroll
            for (int m = 0; m < 4; ++m) { const int r = ai * HALF + wr * 64 + m * 16 + fr; const float rs = S[r]; const size_t off = (size_t)(u.pm * BM + r) * ldc + col0;
#pragma unroll
                for (int bj = 0; bj < 2; ++bj)
#pragma unroll
                    for (int n = 0; n < 2; ++n) { const f32x4 x = acc[ai][bj][m][n]; *(f32x4*)(out + off + bj * HALF + n * 16) = x;
                        const f32x4 o = x * rs * gv[bj][n]; u32x2v w; w.x = cvt_pk_bf16(o[0], o[1]); w.y = cvt_pk_bf16(o[2], o[3]);
                        *(u32x2v*)(xn + off + bj * HALF + n * 16) = w; } }
    }
};

template <class Epi, class Sched, bool ALIGN_EPI = false, bool SP2 = false>
__device__ __forceinline__ void gemm_phase(PG8_LAS unsigned char* lds, const Gemm g, const Sched& S, const Epi& E) {
    int tid_o = my_tid(g.wave); asm volatile("" : "+v"(tid_o)); const int tid = tid_o, wid = __builtin_amdgcn_readfirstlane(tid >> 6), lane = tid & 63, wr = wid >> 2, wc = wid & 3, fr = lane & 15, fq = lane >> 4;
    const int K = g.K, nt = K / BK;
    unsigned voffA[2], voffB[2];
#pragma unroll
    for (int i = 0; i < 2; ++i) { int R, C; stage_rc(tid * 16 + i * 8192, R, C); const int Rb = Epi::PERM ? ((R & ~31) + perm32(R & 31)) : R;
        voffA[i] = (unsigned)(R * g.lda + C) * 2u; voffB[i] = (unsigned)(Rb * K + C) * 2u; }
    const size_t kstep = (size_t)(BK * 2);
    const size_t hstep = (size_t)HALF * K * 2;
    const size_t tstep = 2 * hstep; const size_t hstepA = (size_t)HALF * g.lda * 2, tstepA = 2 * hstepA;
    const unsigned ldsw = (unsigned)wid * 1024u;
    const int aoff = lds_byte(wr * 64 + fr, fq * 8), boff = lds_byte(wc * 32 + fr, fq * 8);
#define PG8_SA(b, h) (((b) * 2 + (h)) * HTB)
#define PG8_SB(b, h) ((4 + (b) * 2 + (h)) * HTB)
#define PG8_STAGE(bufoff, gbase, voff) do { _Pragma("unroll") for (int _i = 0; _i < 2; ++_i) \
        __builtin_amdgcn_global_load_lds((const unsigned*)((const char*)(gbase) + (voff)[_i]), (PG8_LAS unsigned*)(lds + (bufoff) + ldsw + _i * 8192), 16, 0, 0); } while (0)
#define PG8_LDA(dst, b, h) do { _Pragma("unroll") for (int m = 0; m < 4; ++m) _Pragma("unroll") for (int k = 0; k < 2; ++k) dst[m][k] = *(const PG8_LAS bf16x8*)(lds + PG8_SA(b, h) + aoff + m * 2048 + k * 1024); } while (0)
#define PG8_LDB(dst, b, h) do { _Pragma("unroll") for (int n = 0; n < 2; ++n) _Pragma("unroll") for (int k = 0; k < 2; ++k) dst[n][k] = *(const PG8_LAS bf16x8*)(lds + PG8_SB(b, h) + boff + n * 2048 + k * 1024); } while (0)
#define PG8_MMA(ai, bj, At, Bt) do { __builtin_amdgcn_s_setprio(1); _Pragma("unroll") for (int m = 0; m < 4; ++m) _Pragma("unroll") for (int n = 0; n < 2; ++n) _Pragma("unroll") for (int k = 0; k < 2; ++k) \
        acc[ai][bj][m][n] = __builtin_amdgcn_mfma_f32_16x16x32_bf16(Bt[n][k], At[m][k], acc[ai][bj][m][n], 0, 0, 0); __builtin_amdgcn_s_setprio(0); } while (0)
#define PG8_WAIT_V(n) asm volatile("s_waitcnt vmcnt(" #n ")" ::: "memory")
#define PG8_WAIT_L(n) asm volatile("s_waitcnt lgkmcnt(" #n ")" ::: "memory")
#define PG8_BAR __builtin_amdgcn_s_barrier()
#define PG8_SCHED __builtin_amdgcn_sched_barrier(0)
    Unit cur, nxt; int ui = 0;
    if (!S.next(0, cur)) return;
    f32x4 acc[2][2][4][2];
#pragma unroll
    for (int a = 0; a < 2; ++a)
#pragma unroll
        for (int b = 0; b < 2; ++b)
#pragma unroll
            for (int m = 0; m < 4; ++m)
#pragma unroll
                for (int n = 0; n < 2; ++n) acc[a][b][m][n] = (f32x4){0.f, 0.f, 0.f, 0.f};
    bf16x8 At[4][2], B0[2][2], B1[2][2];
    const char* cA = (const char*)g.A + (size_t)cur.pm * tstepA; const char* cB = (const char*)g.Bt + (size_t)cur.pn * tstep;
    S.a_ready(cur);
    if constexpr (SP2) {
        PG8_STAGE(PG8_SB(0, 0), cB, voffB); PG8_STAGE(PG8_SB(0, 1), cB + hstep, voffB); PG8_STAGE(PG8_SA(0, 0), cA, voffA); PG8_STAGE(PG8_SA(0, 1), cA + hstepA, voffA);
        if (wr == 1) PG8_BAR;
        PG8_WAIT_V(2); PG8_BAR;
        PG8_STAGE(PG8_SB(1, 0), cB + kstep, voffB); PG8_STAGE(PG8_SA(1, 0), cA + kstep, voffA); PG8_STAGE(PG8_SB(1, 1), cB + hstep + kstep, voffB);
        PG8_WAIT_V(6); PG8_BAR;
    } else {
        PG8_STAGE(PG8_SB(0, 0), cB, voffB); PG8_STAGE(PG8_SA(0, 0), cA, voffA); PG8_STAGE(PG8_SB(0, 1), cB + hstep, voffB); PG8_STAGE(PG8_SA(0, 1), cA + hstepA, voffA);
        if (wr == 1) PG8_BAR;
        PG8_WAIT_V(4); PG8_BAR;
        PG8_STAGE(PG8_SB(1, 0), cB + kstep, voffB); PG8_STAGE(PG8_SA(1, 0), cA + kstep, voffA); PG8_STAGE(PG8_SB(1, 1), cB + hstep + kstep, voffB);
        PG8_WAIT_V(6); PG8_BAR;
    }
    for (;;) {
        const bool has_next = S.next(ui + 1, nxt);
        const char* nA = has_next ? (const char*)g.A + (size_t)nxt.pm * tstepA : cA; const char* nB = has_next ? (const char*)g.Bt + (size_t)nxt.pn * tstep : cB;
        for (int t = 0; t < nt; t += 2) {
            const bool last = (t == nt - 2);
            const char* a1 = cA + (size_t)(t + 1) * kstep;
            const char* a2 = last ? nA : cA + (size_t)(t + 2) * kstep; const char* b2 = last ? nB : cB + (size_t)(t + 2) * kstep;
            const char* a3 = a2 + kstep; const char* b3 = b2 + kstep;
            if (last && has_next) S.a_ready(nxt);
            if constexpr (SP2) {
            PG8_LDB(B0, 0, 0); PG8_LDB(B1, 0, 1); PG8_SCHED; PG8_LDA(At, 0, 0); PG8_STAGE(PG8_SA(1, 1), a1 + hstepA, voffA);
            PG8_WAIT_V(8); PG8_WAIT_L(0); PG8_BAR; PG8_MMA(0, 0, At, B0); PG8_MMA(0, 1, At, B1); PG8_BAR; PG8_SCHED;
            PG8_LDA(At, 0, 1); PG8_STAGE(PG8_SB(0, 0), b2, voffB); PG8_STAGE(PG8_SB(0, 1), b2 + hstep, voffB); PG8_STAGE(PG8_SA(0, 0), a2, voffA);
            PG8_WAIT_V(8); PG8_WAIT_L(0); PG8_BAR; PG8_MMA(1, 0, At, B0); PG8_MMA(1, 1, At, B1); PG8_BAR; PG8_SCHED;
            PG8_LDB(B0, 1, 0); PG8_LDB(B1, 1, 1); PG8_SCHED; PG8_LDA(At, 1, 0); PG8_STAGE(PG8_SA(0, 1), a2 + hstepA, voffA);
            PG8_WAIT_V(8); PG8_WAIT_L(0); PG8_BAR; PG8_MMA(0, 0, At, B0); PG8_MMA(0, 1, At, B1); PG8_BAR; PG8_SCHED;
            PG8_LDA(At, 1, 1); PG8_STAGE(PG8_SB(1, 0), b3, voffB); PG8_STAGE(PG8_SB(1, 1), b3 + hstep, voffB); PG8_STAGE(PG8_SA(1, 0), a3, voffA);
            PG8_WAIT_V(8); PG8_WAIT_L(0); PG8_BAR; PG8_MMA(1, 0, At, B0); PG8_MMA(1, 1, At, B1); PG8_BAR; PG8_SCHED;
            } else {
            PG8_LDB(B0, 0, 0); PG8_SCHED; PG8_LDA(At, 0, 0); PG8_STAGE(PG8_SA(1, 1), a1 + hstepA, voffA);
            PG8_WAIT_L(8); PG8_BAR; PG8_WAIT_L(0); PG8_MMA(0, 0, At, B0); PG8_BAR; PG8_SCHED;
            PG8_LDB(B1, 0, 1); PG8_STAGE(PG8_SB(0, 0), b2, voffB);
            PG8_BAR; PG8_WAIT_L(0); PG8_MMA(0, 1, At, B1); PG8_BAR;
            PG8_LDA(At, 0, 1); PG8_STAGE(PG8_SA(0, 0), a2, voffA);
            PG8_BAR; PG8_WAIT_L(0); PG8_MMA(1, 0, At, B0); PG8_BAR; PG8_SCHED;
            PG8_STAGE(PG8_SB(0, 1), b2 + hstep, voffB);
            PG8_WAIT_V(6); PG8_BAR; PG8_MMA(1, 1, At, B1); PG8_BAR;
            PG8_LDB(B0, 1, 0); PG8_SCHED; PG8_LDA(At, 1, 0); PG8_STAGE(PG8_SA(0, 1), a2 + hstepA, voffA);
            PG8_WAIT_L(8); PG8_BAR; PG8_WAIT_L(0); PG8_MMA(0, 0, At, B0); PG8_BAR; PG8_SCHED;
            PG8_LDB(B1, 1, 1); PG8_STAGE(PG8_SB(1, 0), b3, voffB);
            PG8_BAR; PG8_WAIT_L(0); PG8_MMA(0, 1, At, B1); PG8_BAR;
            PG8_LDA(At, 1, 1); PG8_STAGE(PG8_SA(1, 0), a3, voffA);
            PG8_BAR; PG8_WAIT_L(0); PG8_MMA(1, 0, At, B0); PG8_BAR; PG8_SCHED;
            PG8_STAGE(PG8_SB(1, 1), b3 + hstep, voffB);
            PG8_WAIT_V(6); PG8_BAR; PG8_MMA(1, 1, At, B1); PG8_BAR;
            }
        }
        if constexpr (ALIGN_EPI) { if (wr == 0) PG8_BAR; }
        if constexpr (!Epi::AFTER_DRAIN) { E(acc, cur, wr, wc, fr, fq); S.done(cur); }
        if (!has_next) break;
#pragma unroll
        for (int a = 0; a < 2; ++a)
#pragma unroll
            for (int b = 0; b < 2; ++b)
#pragma unroll
                for (int m = 0; m < 4; ++m)
#pragma unroll
                    for (int n = 0; n < 2; ++n) acc[a][b][m][n] = (f32x4){0.f, 0.f, 0.f, 0.f};
        cur = nxt; cA = nA; cB = nB; ++ui;
        if constexpr (ALIGN_EPI) { if (wr == 1) PG8_BAR; }
    }
    PG8_WAIT_V(0);
    if constexpr (!ALIGN_EPI) { if (wr == 0) PG8_BAR; }
    PG8_BAR;
    if constexpr (Epi::AFTER_DRAIN) { E.fused(acc, cur, wr, wc, fr, fq, lds, wid, lane); S.done(cur); }
#undef PG8_SA
#undef PG8_SB
#undef PG8_STAGE
#undef PG8_LDA
#undef PG8_LDB
#undef PG8_MMA
#undef PG8_WAIT_V
#undef PG8_WAIT_L
#undef PG8_BAR
#undef PG8_SCHED
}
}

namespace att {
#define LAS __attribute__((address_space(3)))
typedef unsigned short bf16_t;
typedef short bf16x8 __attribute__((ext_vector_type(8)));
typedef short s16x4 __attribute__((ext_vector_type(4)));
typedef float f32x16 __attribute__((ext_vector_type(16)));
typedef float f32x4 __attribute__((ext_vector_type(4)));
typedef unsigned u32x4 __attribute__((ext_vector_type(4)));
constexpr int SEQ = 2048, PITCH = 6144, TILE = 16384, SCR_OFF = 131072;
constexpr float SCALE = 0.08838834764831845f, LOG2E = 1.4426950408889634f, EPS = 1e-6f;
#define SBAR() __builtin_amdgcn_sched_barrier(0)
#define VMW() asm volatile("s_waitcnt vmcnt(0)" ::: "memory")
#define GLDS(gptr, ldsptr) __builtin_amdgcn_global_load_lds((const unsigned*)(gptr), (LAS unsigned*)(ldsptr), 16, 0, 0)

__device__ __forceinline__ int crow(int r, int hi) { return (r & 3) + 8 * (r >> 2) + 4 * hi; }
__device__ __forceinline__ unsigned cvtpk(float lo, float hi) { unsigned r; asm volatile("v_cvt_pk_bf16_f32 %0, %1, %2" : "=v"(r) : "v"(lo), "v"(hi)); return r; }
__device__ __forceinline__ int swap23(int k) { return (k & ~0xC) | ((k & 4) << 1) | ((k & 8) >> 1); }
__device__ __forceinline__ unsigned kfmt_goff(int b) { const int row = b >> 8, cp = (b & 255) >> 4, ch = cp ^ (row & 7); return (unsigned)(row * PITCH + ch * 8); }
__device__ __forceinline__ unsigned vfmt_goff(int b) { const int sub = b >> 9, kkhi = sub >> 2, cblk = sub & 3, within = (b & 511) >> 1, kklo = within >> 5, cc = within & 31;
    const int k = swap23(kkhi * 8 + kklo); return (unsigned)(k * PITCH + cblk * 32 + cc); }
__device__ __forceinline__ int v_rd_base(int lane) { return ((lane & 3) << 3) | (((lane >> 2) & 3) << 6) | (((lane >> 4) & 1) << 5) | (((lane >> 5) & 1) << 8); }
#define KSWZ(row, colB) ((row) * 256 + ((colB) ^ (((row) & 7) << 4)))

__device__ __forceinline__ void qkt(f32x16& p0, f32x16& p1, const LAS char* Kt, int r32, int hi, const bf16x8* qr) {
    p0 = f32x16{}; p1 = f32x16{};
    const LAS char* kb[4];
#pragma unroll
    for (int dd = 0; dd < 4; ++dd) kb[dd] = Kt + KSWZ(r32, (dd * 16 + hi * 8) * 2);
#pragma unroll
    for (int d0 = 0; d0 < 8; ++d0) { const LAS char* a = kb[d0 & 3] + (d0 >> 2) * 128;
        const bf16x8 b0 = *reinterpret_cast<const LAS bf16x8*>(a);
        const bf16x8 b1 = *reinterpret_cast<const LAS bf16x8*>(a + 32 * 256);
        p0 = __builtin_amdgcn_mfma_f32_32x32x16_bf16(b0, qr[d0], p0, 0, 0, 0);
        p1 = __builtin_amdgcn_mfma_f32_32x32x16_bf16(b1, qr[d0], p1, 0, 0, 0); }
}
template <bool ALL16>
__device__ __forceinline__ void qkt_b(f32x16& p0, f32x16& p1, unsigned kt, int r32, int hi, const bf16x8* qr) {
    unsigned kb0 = kt + KSWZ(r32, (0 * 16 + hi * 8) * 2), kb1 = kt + KSWZ(r32, (1 * 16 + hi * 8) * 2), kb2 = kt + KSWZ(r32, (2 * 16 + hi * 8) * 2), kb3 = kt + KSWZ(r32, (3 * 16 + hi * 8) * 2);
#define KRD(dst, base, off) asm volatile("ds_read_b128 %0, %1 offset:%2" : "=&v"(dst) : "v"(base), "i"(off) : "memory")
#define KRD8(a, o_) do { KRD(a##0, kb0, (o_)); KRD(a##1, kb1, (o_)); KRD(a##2, kb2, (o_)); KRD(a##3, kb3, (o_)); KRD(a##4, kb0, (o_) + 128); KRD(a##5, kb1, (o_) + 128); KRD(a##6, kb2, (o_) + 128); KRD(a##7, kb3, (o_) + 128); } while (0)
#define KMMA8(p, a) do { p = __builtin_amdgcn_mfma_f32_32x32x16_bf16(a##0, qr[0], p, 0, 0, 0); p = __builtin_amdgcn_mfma_f32_32x32x16_bf16(a##1, qr[1], p, 0, 0, 0); \
        p = __builtin_amdgcn_mfma_f32_32x32x16_bf16(a##2, qr[2], p, 0, 0, 0); p = __builtin_amdgcn_mfma_f32_32x32x16_bf16(a##3, qr[3], p, 0, 0, 0); \
        p = __builtin_amdgcn_mfma_f32_32x32x16_bf16(a##4, qr[4], p, 0, 0, 0); p = __builtin_amdgcn_mfma_f32_32x32x16_bf16(a##5, qr[5], p, 0, 0, 0); \
        p = __builtin_amdgcn_mfma_f32_32x32x16_bf16(a##6, qr[6], p, 0, 0, 0); p = __builtin_amdgcn_mfma_f32_32x32x16_bf16(a##7, qr[7], p, 0, 0, 0); } while (0)
    bf16x8 a0, a1, a2, a3, a4, a5, a6, a7;
    p0 = f32x16{}; p1 = f32x16{};
    if constexpr (ALL16) {
        bf16x8 c0, c1, c2, c3, c4, c5, c6, c7;
        KRD8(a, 0); KRD8(c, 8192);
        asm volatile("s_waitcnt lgkmcnt(8)" ::: "memory"); SBAR();
        KMMA8(p0, a);
        asm volatile("s_waitcnt lgkmcnt(0)" ::: "memory"); SBAR();
        KMMA8(p1, c);
    } else {
        KRD8(a, 0);
        asm volatile("s_waitcnt lgkmcnt(0)" ::: "memory"); SBAR();
        KMMA8(p0, a);
        SBAR();
        KRD8(a, 8192);
        asm volatile("s_waitcnt lgkmcnt(0)" ::: "memory"); SBAR();
        KMMA8(p1, a);
    }
#undef KRD
#undef KRD8
#undef KMMA8
}
template <int ND0>
__device__ __forceinline__ void pv_tile(f32x16* o, unsigned vb, bf16x8 pa0, bf16x8 pa1, bf16x8 pa2, bf16x8 pa3) {
#define TRRD(dst, off) asm volatile("ds_read_b64_tr_b16 %0, %1 offset:%2" : "=&v"(dst) : "v"(vb), "i"(off) : "memory")
#define PV_D0(d0) do { s16x4 l0, l1, l2, l3, h0, h1, h2, h3; constexpr int b_ = ((d0) >> 2) * TILE + ((d0) & 3) * 512; \
        TRRD(l0, b_); TRRD(h0, b_ + 2048); TRRD(l1, b_ + 4096); TRRD(h1, b_ + 6144); TRRD(l2, b_ + 8192); TRRD(h2, b_ + 10240); TRRD(l3, b_ + 12288); TRRD(h3, b_ + 14336); \
        asm volatile("s_waitcnt lgkmcnt(0)" ::: "memory"); SBAR(); \
        o[d0] = __builtin_amdgcn_mfma_f32_32x32x16_bf16(pa0, (bf16x8){l0[0], l0[1], l0[2], l0[3], h0[0], h0[1], h0[2], h0[3]}, o[d0], 0, 0, 0); \
        o[d0] = __builtin_amdgcn_mfma_f32_32x32x16_bf16(pa1, (bf16x8){l1[0], l1[1], l1[2], l1[3], h1[0], h1[1], h1[2], h1[3]}, o[d0], 0, 0, 0); \
        o[d0] = __builtin_amdgcn_mfma_f32_32x32x16_bf16(pa2, (bf16x8){l2[0], l2[1], l2[2], l2[3], h2[0], h2[1], h2[2], h2[3]}, o[d0], 0, 0, 0); \
        o[d0] = __builtin_amdgcn_mfma_f32_32x32x16_bf16(pa3, (bf16x8){l3[0], l3[1], l3[2], l3[3], h3[0], h3[1], h3[2], h3[3]}, o[d0], 0, 0, 0); } while (0)
    PV_D0(0); PV_D0(1); PV_D0(2); PV_D0(3);
    if constexpr (ND0 > 4) { PV_D0(4); PV_D0(5); PV_D0(6); PV_D0(7); }
#undef PV_D0
#undef TRRD
}
template <int ND0>
__device__ __forceinline__ void pv_tile2(f32x16* o, unsigned vb, bf16x8 pa0, bf16x8 pa1, bf16x8 pa2, bf16x8 pa3) {
#define TRRD(dst, off) asm volatile("ds_read_b64_tr_b16 %0, %1 offset:%2" : "=&v"(dst) : "v"(vb), "i"(off) : "memory")
#define PV_OFF(d0) (((d0) >> 2) * TILE + ((d0) & 3) * 512)
#define PV_RD(S, d0) do { constexpr int b_ = PV_OFF(d0); TRRD(S##l0, b_); TRRD(S##h0, b_ + 2048); TRRD(S##l1, b_ + 4096); TRRD(S##h1, b_ + 6144); TRRD(S##l2, b_ + 8192); TRRD(S##h2, b_ + 10240); TRRD(S##l3, b_ + 12288); TRRD(S##h3, b_ + 14336); } while (0)
#define PV_MM(S, d0) do { \
        o[d0] = __builtin_amdgcn_mfma_f32_32x32x16_bf16(pa0, (bf16x8){S##l0[0], S##l0[1], S##l0[2], S##l0[3], S##h0[0], S##h0[1], S##h0[2], S##h0[3]}, o[d0], 0, 0, 0); \
        o[d0] = __builtin_amdgcn_mfma_f32_32x32x16_bf16(pa1, (bf16x8){S##l1[0], S##l1[1], S##l1[2], S##l1[3], S##h1[0], S##h1[1], S##h1[2], S##h1[3]}, o[d0], 0, 0, 0); \
        o[d0] = __builtin_amdgcn_mfma_f32_32x32x16_bf16(pa2, (bf16x8){S##l2[0], S##l2[1], S##l2[2], S##l2[3], S##h2[0], S##h2[1], S##h2[2], S##h2[3]}, o[d0], 0, 0, 0); \
        o[d0] = __builtin_amdgcn_mfma_f32_32x32x16_bf16(pa3, (bf16x8){S##l3[0], S##l3[1], S##l3[2], S##l3[3], S##h3[0], S##h3[1], S##h3[2], S##h3[3]}, o[d0], 0, 0, 0); } while (0)
#define PV_W8() do { asm volatile("s_waitcnt lgkmcnt(8)" ::: "memory"); SBAR(); } while (0)
#define PV_W0() do { asm volatile("s_waitcnt lgkmcnt(0)" ::: "memory"); SBAR(); } while (0)
    s16x4 Al0, Al1, Al2, Al3, Ah0, Ah1, Ah2, Ah3, Bl0, Bl1, Bl2, Bl3, Bh0, Bh1, Bh2, Bh3;
    PV_RD(A, 0);
    PV_RD(B, 1); PV_W8(); PV_MM(A, 0); SBAR();
    PV_RD(A, 2); PV_W8(); PV_MM(B, 1); SBAR();
    if constexpr (ND0 > 4) {
        PV_RD(B, 3); PV_W8(); PV_MM(A, 2); SBAR();
        PV_RD(A, 4); PV_W8(); PV_MM(B, 3); SBAR();
        PV_RD(B, 5); PV_W8(); PV_MM(A, 4); SBAR();
        PV_RD(A, 6); PV_W8(); PV_MM(B, 5); SBAR();
        PV_RD(B, 7); PV_W8(); PV_MM(A, 6); SBAR();
        PV_W0(); PV_MM(B, 7);
    } else {
        PV_RD(B, 3); PV_W8(); PV_MM(A, 2); SBAR();
        PV_W0(); PV_MM(B, 3);
    }
#undef PV_W0
#undef PV_W8
#undef PV_MM
#undef PV_RD
#undef PV_OFF
#undef TRRD
}
#define PK4(P, B_, OUT) do { const unsigned a0 = cvtpk(P[B_+0], P[B_+1]), a1 = cvtpk(P[B_+2], P[B_+3]); \
        const unsigned b0 = cvtpk(P[B_+4], P[B_+5]), b1 = cvtpk(P[B_+6], P[B_+7]); \
        auto r0 = __builtin_amdgcn_permlane32_swap(a0, b0, false, false); auto r1 = __builtin_amdgcn_permlane32_swap(a1, b1, false, false); \
        u32x4 w = {r0[0], r1[0], r0[1], r1[1]}; OUT = *reinterpret_cast<bf16x8*>(&w); } while (0)

__device__ __forceinline__ void sb_tile(f32x16& p0, f32x16& p1, float& carry, int dq, bool need_mask, int hi, bf16x8& pa0, bf16x8& pa1, bf16x8& pa2, bf16x8& pa3) {
    constexpr float C2 = SCALE * LOG2E;
    const float NEG = -__builtin_inff();
    f32x16 l0, l1;
#pragma unroll
    for (int r = 0; r < 16; ++r) {
        { const float z = p0[r] * C2; p0[r] = z; const float t = __builtin_amdgcn_exp2f(-__builtin_fabsf(z)); l0[r] = fmaxf(z, 0.f) + __builtin_amdgcn_logf(1.0f + t); }
        { const float z = p1[r] * C2; p1[r] = z; const float t = __builtin_amdgcn_exp2f(-__builtin_fabsf(z)); l1[r] = fmaxf(z, 0.f) + __builtin_amdgcn_logf(1.0f + t); }
    }
    if (need_mask) {
#pragma unroll
        for (int r = 0; r < 16; ++r) { const int c = (r & 3) + 8 * (r >> 2);
            if (dq - c <= 0) { l0[r] = 0.f; p0[r] = NEG; }
            if (dq - c - 32 <= 0) { l1[r] = 0.f; p1[r] = NEG; } }
    }
    float gs[8];
#pragma unroll
    for (int g = 0; g < 4; ++g) { gs[g] = (l0[4 * g] + l0[4 * g + 1]) + (l0[4 * g + 2] + l0[4 * g + 3]); gs[4 + g] = (l1[4 * g] + l1[4 * g + 1]) + (l1[4 * g + 2] + l1[4 * g + 3]); }
    float T = -carry, off[8];
#pragma unroll
    for (int i = 7; i >= 0; --i) { auto rr = __builtin_amdgcn_permlane32_swap(__float_as_uint(gs[i]), __float_as_uint(gs[i]), false, false);
        const float a = __uint_as_float(rr[0]), b = __uint_as_float(rr[1]);
        off[i] = hi ? T : T + b; T = T + (a + b); }
    carry = -T;
#pragma unroll
    for (int g = 0; g < 4; ++g) {
        { float G = off[g] + l0[4 * g + 3]; p0[4 * g + 3] = __builtin_amdgcn_exp2f(p0[4 * g + 3] - G); G += l0[4 * g + 2]; p0[4 * g + 2] = __builtin_amdgcn_exp2f(p0[4 * g + 2] - G);
          G += l0[4 * g + 1]; p0[4 * g + 1] = __builtin_amdgcn_exp2f(p0[4 * g + 1] - G); G += l0[4 * g]; p0[4 * g] = __builtin_amdgcn_exp2f(p0[4 * g] - G); }
        { float G = off[4 + g] + l1[4 * g + 3]; p1[4 * g + 3] = __builtin_amdgcn_exp2f(p1[4 * g + 3] - G); G += l1[4 * g + 2]; p1[4 * g + 2] = __builtin_amdgcn_exp2f(p1[4 * g + 2] - G);
          G += l1[4 * g + 1]; p1[4 * g + 1] = __builtin_amdgcn_exp2f(p1[4 * g + 1] - G); G += l1[4 * g]; p1[4 * g] = __builtin_amdgcn_exp2f(p1[4 * g] - G); }
    }
    PK4(p0, 0, pa0); PK4(p0, 8, pa1); PK4(p1, 0, pa2); PK4(p1, 8, pa3);
}

constexpr float THR = 8.f;
__device__ __forceinline__ void mask_incl(f32x16& p0, f32x16& p1, int dq) {
    const float NEG = -__builtin_inff();
#pragma unroll
    for (int r = 0; r < 16; ++r) { const int c = (r & 3) + 8 * (r >> 2);
        if (dq - c < 0) p0[r] = NEG;
        if (dq - c - 32 < 0) p1[r] = NEG; }
}
__device__ __forceinline__ void partialSM(f32x16& p0, f32x16& p1, float& m_reg, float& alpha) {
    float pmax = p0[0];
#pragma unroll
    for (int r = 1; r < 16; ++r) pmax = fmaxf(pmax, p0[r]);
#pragma unroll
    for (int r = 0; r < 16; ++r) pmax = fmaxf(pmax, p1[r]);
    { auto rr = __builtin_amdgcn_permlane32_swap(__float_as_uint(pmax), __float_as_uint(pmax), false, false);
      pmax = fmaxf(__uint_as_float(rr[0]), __uint_as_float(rr[1])); }
    constexpr float C2 = LOG2E * SCALE;
    float mn;
    if (__builtin_expect(__all((pmax - m_reg) * SCALE <= THR), 1)) { mn = m_reg; alpha = 1.f; }
    else { mn = fmaxf(m_reg, pmax); alpha = __builtin_amdgcn_exp2f((m_reg - mn) * C2); m_reg = mn; }
    const float mnL = -mn * C2;
#pragma unroll
    for (int r = 0; r < 16; ++r) { p0[r] = __builtin_amdgcn_exp2f(fmaf(p0[r], C2, mnL)); p1[r] = __builtin_amdgcn_exp2f(fmaf(p1[r], C2, mnL)); }
}
__device__ __forceinline__ void finishSM(f32x16& p0, f32x16& p1, float alpha, float& l_reg, bf16x8& pa0, bf16x8& pa1, bf16x8& pa2, bf16x8& pa3) {
    float ps = 0;
#pragma unroll
    for (int r = 0; r < 16; ++r) ps += p0[r];
#pragma unroll
    for (int r = 0; r < 16; ++r) ps += p1[r];
    { auto rr = __builtin_amdgcn_permlane32_swap(__float_as_uint(ps), __float_as_uint(ps), false, false);
      ps = __uint_as_float(rr[0]) + __uint_as_float(rr[1]); }
    l_reg = l_reg * alpha + ps;
    PK4(p0, 0, pa0); PK4(p0, 8, pa1); PK4(p1, 0, pa2); PK4(p1, 8, pa3);
}

__device__ __forceinline__ void sb_unit(LAS char* lds, bf16_t* QKV, int b, int h, int qb, int wave0) {
    int tid_o = my_tid(wave0); asm volatile("" : "+v"(tid_o)); const int tid = tid_o, wid = __builtin_amdgcn_readfirstlane(tid >> 6), lane = tid & 63, r32 = lane & 31, hi = lane >> 5;
    const int P0 = qb * 256, qlo = P0 + wid * 32, qm = qlo + r32 - 4 * hi;
    const unsigned kg0 = kfmt_goff(wid * 1024 + lane * 16), kg1 = kfmt_goff((wid + 8) * 1024 + lane * 16);
    const unsigned vg0 = vfmt_goff(wid * 1024 + lane * 16), vg1 = vfmt_goff((wid + 8) * 1024 + lane * 16);
    bf16_t* rowsq = QKV + (size_t)(b * SEQ + qlo) * PITCH + h * 128;
    bf16x8 qr[8];
#pragma unroll
    for (int d0 = 0; d0 < 8; ++d0) qr[d0] = *reinterpret_cast<const bf16x8*>(rowsq + (size_t)r32 * PITCH + d0 * 16 + hi * 8);
    const bf16_t* Kg = QKV + (size_t)(b * SEQ) * PITCH + 2048 + h * 128;
    const bf16_t* Vg = QKV + (size_t)(b * SEQ) * PITCH + 4096 + h * 128;
    const int NT = 4 * qb + 4;
    const unsigned vbase = (unsigned)(size_t)(lds) + (unsigned)v_rd_base(lane);
#define SB_STAGE(t, bf) do { const size_t ro_ = (size_t)(t) * 64 * PITCH; LAS char* d_ = lds + (bf) * 2 * TILE; \
        GLDS(Kg + ro_ + kg0, d_ + wid * 1024); GLDS(Kg + ro_ + kg1, d_ + (wid + 8) * 1024); \
        GLDS(Vg + ro_ + vg0, d_ + TILE + wid * 1024); GLDS(Vg + ro_ + vg1, d_ + TILE + (wid + 8) * 1024); } while (0)
    f32x16 o[4] = {}; float carry = 0.f;
    LAS unsigned* dflag = (LAS unsigned*)(lds + SCR_OFF);
    bool fin = false;
    SB_STAGE(NT - 1, 0); VMW(); __syncthreads();
    for (int it = 0; it < NT; ++it) {
        const int t = NT - 1 - it, bf = it & 1, kb = t * 64;
        if (it + 1 < NT) SB_STAGE(t - 1, bf ^ 1);
        if (kb < qlo + 31 && !fin) {
            f32x16 p0, p1; bf16x8 pa0, pa1, pa2, pa3;
            qkt_b<true>(p0, p1, (unsigned)(size_t)(lds + bf * 2 * TILE), r32, hi, qr);
            sb_tile(p0, p1, carry, qm - kb, kb + 63 >= qlo, hi, pa0, pa1, pa2, pa3);
            pv_tile2<4>(o, vbase + bf * 2 * TILE + TILE, pa0, pa1, pa2, pa3);
            fin = __all(carry < -152.0f);
        }
        if (lane == 0) dflag[bf * 8 + wid] = fin ? 1u : 0u;
        VMW(); __syncthreads();
        if (__all(dflag[bf * 8 + (lane & 7)] != 0u)) break;
    }
#undef SB_STAGE
#pragma unroll
    for (int r = 0; r < 16; ++r) { const int orow = crow(r, hi);
#pragma unroll
        for (int d0 = 0; d0 < 4; ++d0) *(unsigned short*)(rowsq + (size_t)orow * PITCH + d0 * 32 + r32) = (unsigned short)cvtpk(o[d0][r], 0.f); }
}

template <bool FIXED>
__device__ __forceinline__ void df_unit(LAS char* lds, bf16_t* QKV, const float* gsub, float lam, float post, int b, int h, int qb, int wave0, float mfix2) {
    int tid_o = my_tid(wave0); asm volatile("" : "+v"(tid_o)); const int tid = tid_o, wid = __builtin_amdgcn_readfirstlane(tid >> 6), lane = tid & 63, r32 = lane & 31, hi = lane >> 5;
    const int mp = wid >> 2, wq = wid & 3;
    const int P0 = qb * 128, qlo = P0 + wq * 32, qm = qlo + r32 - 4 * hi;
    const unsigned kg0 = kfmt_goff(wid * 1024 + lane * 16), kg1 = kfmt_goff((wid + 8) * 1024 + lane * 16);
    const unsigned vg0 = vfmt_goff(wid * 1024 + lane * 16), vg1 = vfmt_goff((wid + 8) * 1024 + lane * 16);
    bf16_t* rowsq = QKV + (size_t)(b * SEQ + qlo) * PITCH + h * 256;
    bf16x8 qr[8];
#pragma unroll
    for (int d0 = 0; d0 < 8; ++d0) qr[d0] = *reinterpret_cast<const bf16x8*>(rowsq + (size_t)r32 * PITCH + mp * 128 + d0 * 16 + hi * 8);
    const bf16_t* Kg = QKV + (size_t)(b * SEQ) * PITCH + 2048 + h * 256;
    const bf16_t* Vg = QKV + (size_t)(b * SEQ) * PITCH + 4096 + h * 256;
    const int NT = 2 * qb + 2;
    const unsigned vbase = (unsigned)(size_t)(lds) + (unsigned)v_rd_base(lane);
    LAS float* wsf = (LAS float*)(lds + SCR_OFF) + wid * 64; LAS float* li_l = wsf; LAS float* al_l = wsf + 32;
#define DF_STAGE(t, bf) do { const size_t ro_ = (size_t)(t) * 64 * PITCH; LAS char* d_ = lds + (bf) * 4 * TILE; \
        GLDS(Kg + ro_ + kg0, d_ + wid * 1024); GLDS(Kg + ro_ + kg1, d_ + (wid + 8) * 1024); \
        GLDS(Kg + 128 + ro_ + kg0, d_ + TILE + wid * 1024); GLDS(Kg + 128 + ro_ + kg1, d_ + TILE + (wid + 8) * 1024); \
        GLDS(Vg + ro_ + vg0, d_ + 2 * TILE + wid * 1024); GLDS(Vg + ro_ + vg1, d_ + 2 * TILE + (wid + 8) * 1024); \
        GLDS(Vg + 128 + ro_ + vg0, d_ + 3 * TILE + wid * 1024); GLDS(Vg + 128 + ro_ + vg1, d_ + 3 * TILE + (wid + 8) * 1024); } while (0)
    f32x16 o[8] = {}; float m_reg = -1e30f, l_reg = 0.f;
    DF_STAGE(0, 0); VMW(); __syncthreads();
    for (int t = 0; t < NT; ++t) {
        const int bf = t & 1, kb = t * 64;
        if (t + 1 < NT) DF_STAGE(t + 1, bf ^ 1);
        if (kb <= qlo + 31) {
            f32x16 p0, p1; bf16x8 pa0, pa1, pa2, pa3; float alpha;
            qkt_b<false>(p0, p1, (unsigned)(size_t)(lds + bf * 4 * TILE + mp * TILE), r32, hi, qr);
            if (kb + 63 > qlo) mask_incl(p0, p1, qm - kb);
            if constexpr (FIXED) { constexpr float C2f = LOG2E * SCALE; alpha = 1.f;
#pragma unroll
                for (int r = 0; r < 16; ++r) { p0[r] = __builtin_amdgcn_exp2f(fmaf(p0[r], C2f, mfix2)); p1[r] = __builtin_amdgcn_exp2f(fmaf(p1[r], C2f, mfix2)); } }
            else {
            partialSM(p0, p1, m_reg, alpha);
            if (__any(alpha < 1.f)) { if (hi == 0) al_l[r32] = alpha; asm volatile("s_waitcnt lgkmcnt(0)" ::: "memory");
#pragma unroll
                for (int r = 0; r < 16; ++r) { const float a = al_l[crow(r, hi)];
#pragma unroll
                    for (int d = 0; d < 8; ++d) o[d][r] *= a; } }
            }
            finishSM(p0, p1, alpha, l_reg, pa0, pa1, pa2, pa3);
            pv_tile2<8>(o, vbase + bf * 4 * TILE + 2 * TILE, pa0, pa1, pa2, pa3);
        }
        VMW(); __syncthreads();
    }
#undef DF_STAGE
    if (hi == 0) li_l[r32] = l_reg; asm volatile("s_waitcnt lgkmcnt(0)" ::: "memory");
    float rli[16];
#pragma unroll
    for (int r = 0; r < 16; ++r) rli[r] = 1.0f / li_l[crow(r, hi)];
    LAS float* xch = (LAS float*)lds + wq * 8192 + lane;
    if (mp == 1) {
#pragma unroll
        for (int d = 0; d < 8; ++d)
#pragma unroll
            for (int r = 0; r < 16; ++r) xch[(d * 16 + r) * 64] = o[d][r] * (rli[r] * lam);
    }
    __syncthreads();
    if (mp == 0) {
        float ssq[16];
#pragma unroll
        for (int r = 0; r < 16; ++r) ssq[r] = 0.f;
#pragma unroll
        for (int d = 0; d < 8; ++d)
#pragma unroll
            for (int r = 0; r < 16; ++r) { const float v = o[d][r] * rli[r] - xch[(d * 16 + r) * 64]; o[d][r] = v; ssq[r] += v * v; }
#pragma unroll
        for (int r = 0; r < 16; ++r) { float s = ssq[r]; s = xsum<1>(s); s = xsum<2>(s); s = xsum<4>(s); s = xsum<8>(s); s = xsum<16>(s);
            ssq[r] = post * __builtin_amdgcn_rsqf(s * (1.0f / 256.0f) + EPS); }
#pragma unroll
        for (int d = 0; d < 8; ++d) { const float g = gsub[d * 32 + r32];
#pragma unroll
            for (int r = 0; r < 16; ++r) *(unsigned short*)(rowsq + (size_t)crow(r, hi) * PITCH + d * 32 + r32) = (unsigned short)cvtpk(o[d][r] * ssq[r] * g, 0.f); }
    }
    __syncthreads();
}
}

#define LAS __attribute__((address_space(3)))
typedef unsigned short bf16;
typedef unsigned v4u __attribute__((ext_vector_type(4)));
typedef float f32x4 __attribute__((ext_vector_type(4)));
constexpr int NWAVES = 8;
constexpr int BATCH = 8, SEQ = 2048, DM = 1024, EW = 2048, N4 = 8192, M = BATCH * SEQ, DEPTH = 4, QKVP = 6144;
constexpr float EPS = 1e-6f;
constexpr size_t MiB = 1u << 20;
constexpr size_t WS_XBUF = 512 * 1024, WS_WIN = 1 * MiB, WS_WOUT = 17 * MiB, WS_XN = 24 * MiB, WS_QKV = 56 * MiB, WS_WOUT2 = 248 * MiB, WS_END = 252 * MiB;
constexpr size_t WS_CNT = 16384, CNT_BANK = 64 * 64 * 4;
constexpr int XL_OFF = 131072 + 2048 + 64;
constexpr int LDS_BYTES = XL_OFF + 4096 + 1024;
constexpr int BARST_OFF = 131072 + 2048;
constexpr size_t CTL_ZERO_BYTES = 16384 + 3 * 16384;
#ifndef MK_MULTI
#define MK_MULTI 0
#endif

__device__ __forceinline__ unsigned f2bf(float f) { unsigned u = __builtin_bit_cast(unsigned, f); return (u + 0x7fffu + ((u >> 16) & 1u)) >> 16; }
__device__ __forceinline__ unsigned pk2(float lo, float hi) { return f2bf(lo) | (f2bf(hi) << 16); }
__device__ __forceinline__ float bflo(unsigned w) { return __uint_as_float(w << 16); }
__device__ __forceinline__ float bfhi(unsigned w) { return __uint_as_float(w & 0xffff0000u); }
__device__ __forceinline__ float wave_sum(float v) {
    v = xsum<1>(v); v = xsum<2>(v); v = xsum<4>(v); v = xsum<8>(v); v = xsum<16>(v); v = xsum<32>(v);
    return v;
}
#define LDS_WAIT() asm volatile("s_waitcnt lgkmcnt(0)" ::: "memory")
struct TrItem { const float* W; bf16* WT; int K, N, k0, n0; bool swz; };
constexpr int TR_I_IN = (DM / 64) * (N4 / 32), TR_I_OUT = (EW / 64) * (DM / 32);
__device__ __forceinline__ TrItem tr_decode(int it, const float* w_in, const float* w_out, bf16* Win_t, bf16* Wout_t, bool swz) {
    TrItem t; int r = it;
    if (r < TR_I_IN) { t.W = w_in; t.WT = Win_t; t.K = DM; t.N = N4; t.swz = swz; } else { r -= TR_I_IN; t.W = w_out; t.WT = Wout_t; t.K = EW; t.N = DM; t.swz = false; }
    const int nblk = t.N / 32; t.k0 = 64 * (r / nblk); t.n0 = 32 * (r % nblk); return t;
}
__device__ __forceinline__ void tr_load(const TrItem& t, int lane, f32x4 (&wv)[8]) {
#pragma unroll
    for (int i = 0; i < 8; ++i) wv[i] = __builtin_nontemporal_load((const f32x4*)(t.W + (size_t)(t.k0 + 8 * i + (lane >> 3)) * t.N + t.n0 + 4 * (lane & 7)));
}
__device__ __forceinline__ void tr_finish(const TrItem& t, LAS float* scr, int lane, const f32x4 (&wv)[8]) {
#pragma unroll
    for (int i = 0; i < 8; ++i) { LAS float* d = scr + (8 * i + (lane >> 3)) * 33 + 4 * (lane & 7); d[0] = wv[i].x; d[1] = wv[i].y; d[2] = wv[i].z; d[3] = wv[i].w; }
    LDS_WAIT(); asm volatile("" ::: "memory");
    const int c = lane & 7;
#pragma unroll
    for (int j = 0; j < 4; ++j) { const int n = (lane >> 3) + 8 * j; const LAS float* s = scr + (8 * c) * 33 + n;
        int nr = t.n0 + n; if (t.swz && nr < 4096) nr = (nr & ~0xC0) | ((nr & 0x40) << 1) | ((nr & 0x80) >> 1);
        v4u o; o.x = pk2(s[0 * 33], s[1 * 33]); o.y = pk2(s[2 * 33], s[3 * 33]); o.z = pk2(s[4 * 33], s[5 * 33]); o.w = pk2(s[6 * 33], s[7 * 33]);
        *(v4u*)(t.WT + (size_t)nr * t.K + t.k0 + 8 * c) = o; }
    LDS_WAIT(); asm volatile("" ::: "memory");
}
__device__ __forceinline__ void convert_weights(const float* w_in, const float* w_out, bf16* Win_t, bf16* Wout_t, bool swz, LAS float* scr, int gw, int NGW, int lane) {
    for (int it = gw; it < TR_I_IN + TR_I_OUT; it += 2 * NGW) {
        const bool two = it + NGW < TR_I_IN + TR_I_OUT;
        const TrItem a = tr_decode(it, w_in, w_out, Win_t, Wout_t, swz), b = tr_decode(two ? it + NGW : it, w_in, w_out, Win_t, Wout_t, swz);
        f32x4 wa[8], wb[8];
        tr_load(a, lane, wa); if (two) tr_load(b, lane, wb);
        tr_finish(a, scr, lane, wa);
        if (two) tr_finish(b, scr, lane, wb);
    }
}
__device__ __forceinline__ void rms_row_to_bf16(const float* xrow, const float* g, bf16* orow, int lane) {
    const f32x4* xr = (const f32x4*)xrow + lane; const f32x4* gr = (const f32x4*)g + lane;
    f32x4 v[4]; float s = 0.f;
#pragma unroll
    for (int j = 0; j < 4; ++j) { v[j] = xr[64 * j]; s += (v[j].x * v[j].x + v[j].y * v[j].y) + (v[j].z * v[j].z + v[j].w * v[j].w); }
    const float rstd = 1.0f / sqrtf(wave_sum(s) * (1.f / DM) + EPS);
    unsigned long long* o8 = (unsigned long long*)orow + lane;
#pragma unroll
    for (int j = 0; j < 4; ++j) { const f32x4 gg = gr[64 * j];
        o8[64 * j] = (unsigned long long)pk2(v[j].x * rstd * gg.x, v[j].y * rstd * gg.y) | ((unsigned long long)pk2(v[j].z * rstd * gg.z, v[j].w * rstd * gg.w) << 32); }
}

#define XB_TMO      128
#define XB_XCNT(j)  (256  + 64 * (j))
#define XB_XSUB(j)  (1280 + 64 * (j))
#define XB_XGEN(j)  (2304 + 64 * (j))
#define XB_TOP      3328
#define XB_TOPGEN   3392
#define XCD_BAR_WORDS 3456
#define XB_SPIN_CAP (1u << 18)

__device__ __forceinline__ unsigned xb_ld(unsigned* p)              { return __hip_atomic_load(p, __ATOMIC_RELAXED, __HIP_MEMORY_SCOPE_AGENT); }
__device__ __forceinline__ unsigned xb_add(unsigned* p, unsigned v) { return __hip_atomic_fetch_add(p, v, __ATOMIC_RELAXED, __HIP_MEMORY_SCOPE_AGENT); }
__device__ __forceinline__ unsigned xb_xcc_id() { return (unsigned)__builtin_amdgcn_s_getreg((3 << 11) | 20) & 0xFu; }
#define XB_SPIN(cond, bar) do { unsigned _sp = 0; while (cond) { __builtin_amdgcn_s_sleep(1); \
    if ((++_sp & 255u) == 0u) { if (xb_ld(&(bar)[XB_TMO])) break; if (_sp > XB_SPIN_CAP) { atomicAdd(&(bar)[XB_TMO], 1u); break; } } } } while (0)

struct XcdBarrier {
    unsigned* bar; unsigned x;
    volatile LAS unsigned* st;
};

__device__ __forceinline__ XcdBarrier xcd_barrier_post(unsigned* bar, volatile LAS unsigned* st) {
    XcdBarrier b; b.bar = bar; b.x = xb_xcc_id(); b.st = st;
    if (threadIdx.x == 0) (void)xb_add(&bar[XB_XCNT(b.x)], 1u);
    return b;
}
__device__ __forceinline__ void xcd_barrier_complete(unsigned* bar, unsigned x, unsigned& nloc, unsigned& nx) {
    const unsigned G = gridDim.x * gridDim.y * gridDim.z;
    unsigned sum, cnt, mine, sp = 0u;
    for (;;) {
        sum = 0u; cnt = 0u; mine = 0u;
#pragma unroll
        for (unsigned j = 0; j < 16; ++j) { const unsigned c = xb_ld(&bar[XB_XCNT(j)]); sum += c; cnt += (c > 0u) ? 1u : 0u; mine = (j == x) ? c : mine; }
        if (sum == G) break;
        __builtin_amdgcn_s_sleep(1);
        if ((++sp & 255u) == 0u) { if (xb_ld(&bar[XB_TMO])) break; if (sp > XB_SPIN_CAP) { atomicAdd(&bar[XB_TMO], 1u); break; } }
    }
    nloc = mine > 0u ? mine : 1u; nx = cnt > 0u ? cnt : 1u;
}

__device__ __forceinline__ void xcd_barrier(const XcdBarrier& b, bool leader) {
    asm volatile("s_waitcnt vmcnt(0)" ::: "memory");
    __syncthreads();
    if (leader) {
        unsigned* bar = b.bar;
        __builtin_amdgcn_s_waitcnt(0);
        unsigned nloc = b.st[0], nx = b.st[1];
        if (nloc == 0u) { xcd_barrier_complete(bar, b.x, nloc, nx); b.st[0] = nloc; b.st[1] = nx; }
        const unsigned old = xb_add(&bar[XB_XSUB(b.x)], 1u);
        const unsigned gen = old / nloc;
        if (old + 1u == (gen + 1u) * nloc) {
            __builtin_amdgcn_fence(__ATOMIC_RELEASE, "agent");
            asm volatile("s_waitcnt vmcnt(0)" ::: "memory");
            const unsigned og = xb_add(&bar[XB_TOP], 1u);
            const unsigned tg = og / nx;
            if (og + 1u == (tg + 1u) * nx) xb_add(&bar[XB_TOPGEN], 1u);
            else XB_SPIN(xb_ld(&bar[XB_TOPGEN]) == tg, bar);
            __builtin_amdgcn_fence(__ATOMIC_ACQUIRE, "agent");
            xb_add(&bar[XB_XGEN(b.x)], 1u);
            asm volatile("s_waitcnt vmcnt(0)" ::: "memory");
        } else {
            XB_SPIN(xb_ld(&bar[XB_XGEN(b.x)]) == gen, bar);
            __builtin_amdgcn_fence(__ATOMIC_ACQUIRE, "agent");
            asm volatile("s_waitcnt vmcnt(0)" ::: "memory");
        }
    }
    __syncthreads();
}

struct Params { const float* in[14]; float* out; unsigned char* ws; int ph_lo, ph_hi, probe, pad; };
#ifndef PROBE
#define PROBE 0
#endif

__global__ void __launch_bounds__(NWAVES * 64, 2) fwd(Params p) {
    extern __shared__ __attribute__((aligned(16))) unsigned char lds_raw[];
    LAS unsigned char* lds = (LAS unsigned char*)lds_raw;
    cg::grid_group grid = cg::this_grid();
    const int wave0 = __builtin_amdgcn_readfirstlane((int)threadIdx.x >> 6);
    if (threadIdx.x < 16) ((LAS unsigned*)(lds + BARST_OFF))[threadIdx.x] = 0u;
    __syncthreads();
    XcdBarrier bar = xcd_barrier_post((unsigned*)p.ws, (volatile LAS unsigned*)(lds + BARST_OFF));
    if (p.ph_lo < 0) grid.sync();
    const int G = gridDim.x, NGW = G * NWAVES;
    unsigned char* ws = p.ws;
    bf16* Win_t = (bf16*)(ws + WS_WIN); bf16* XN = (bf16*)(ws + WS_XN); bf16* QKV = (bf16*)(ws + WS_QKV);
    const float* x = p.in[0];
    float* out = p.out;

    for (int id = p.ph_lo; id < p.ph_hi; ++id) {
        const int L = id / 6, k = id % 6, j = L >> 1; const bool df = (L & 1) != 0;
        const bool fusedn = (G == 256);
        if (k == 2 || (k == 0 && L > 0 && fusedn)) continue;
        if (id > p.ph_lo) xcd_barrier(bar, my_tid(wave0) == 0);
#define PHASE_IDS() int tid_o = my_tid(wave0); asm volatile("" : "+v"(tid_o)); const int tid = tid_o, lane = tid & 63, wave = __builtin_amdgcn_readfirstlane(tid >> 6), gw = blockIdx.x * NWAVES + wave; (void)tid; (void)lane; (void)gw
        const float* nrm = (df ? p.in[4] : p.in[1]) + (size_t)j * DM;
        const float* w_in = (df ? p.in[5] : p.in[2]) + (size_t)j * DM * N4;
        const float* w_out = (df ? p.in[6] : p.in[3]) + (size_t)j * EW * DM;
        const float* hin = (L == 0) ? x : out;
        bf16* Wout_t = (bf16*)(ws + ((L & 1) ? WS_WOUT2 : WS_WOUT));
        if (k == 0) {
            PHASE_IDS();
            LAS float* scr = (LAS float*)(lds + wave * 16384);
            convert_weights(w_in, w_out, Win_t, Wout_t, df, scr, gw, NGW, lane);
            for (int m = gw; m < M; m += 2 * NGW) {
                const int m2 = m + NGW; const bool two = m2 < M;
                const f32x4* xa = (const f32x4*)(hin + (size_t)m * DM) + lane; const f32x4* xb = (const f32x4*)(hin + (size_t)(two ? m2 : m) * DM) + lane; const f32x4* gr = (const f32x4*)nrm + lane;
                f32x4 va[4], vb[4]; float sa = 0.f, sb = 0.f;
#pragma unroll
                for (int jj = 0; jj < 4; ++jj) { va[jj] = xa[64 * jj]; vb[jj] = xb[64 * jj]; }
#pragma unroll
                for (int jj = 0; jj < 4; ++jj) { sa += (va[jj].x * va[jj].x + va[jj].y * va[jj].y) + (va[jj].z * va[jj].z + va[jj].w * va[jj].w); sb += (vb[jj].x * vb[jj].x + vb[jj].y * vb[jj].y) + (vb[jj].z * vb[jj].z + vb[jj].w * vb[jj].w); }
                const float ra = 1.0f / sqrtf(wave_sum(sa) * (1.f / DM) + EPS), rb = 1.0f / sqrtf(wave_sum(sb) * (1.f / DM) + EPS);
                unsigned long long* oa = (unsigned long long*)(XN + (size_t)m * DM) + lane; unsigned long long* ob = (unsigned long long*)(XN + (size_t)m2 * DM) + lane;
#pragma unroll
                for (int jj = 0; jj < 4; ++jj) { const f32x4 gg = gr[64 * jj];
                    oa[64 * jj] = (unsigned long long)pk2(va[jj].x * ra * gg.x, va[jj].y * ra * gg.y) | ((unsigned long long)pk2(va[jj].z * ra * gg.z, va[jj].w * ra * gg.w) << 32);
                    if (two) ob[64 * jj] = (unsigned long long)pk2(vb[jj].x * rb * gg.x, vb[jj].y * rb * gg.y) | ((unsigned long long)pk2(vb[jj].z * rb * gg.z, vb[jj].w * rb * gg.w) << 32); }
            }
        } else if (k == 1) {
            pg8::Gemm g{XN, Win_t, M, QKVP, DM, DM, wave0}; pg8::StaticOrder S; S.init(M, QKVP, G, (int)blockIdx.x);
            PHASE_IDS();
            LAS float* xl = (LAS float*)(lds + XL_OFF);
            if (df) { if (tid < 256) xl[1024 + tid] = (tid < 128 ? p.in[7] + (size_t)j * 128 : p.in[8] + (size_t)j * 128 - 128)[tid]; __syncthreads(); }
            pg8::EpiStoreBf16 E{QKV, QKVP, df ? 1 : 0, xl};
            pg8::gemm_phase<pg8::EpiStoreBf16, pg8::StaticOrder, true, true>(lds, g, S, E);
        } else if (k == 3) {
            PHASE_IDS();
            LAS char* al = (LAS char*)lds;
            if (!df) {
                for (int jb = blockIdx.x; jb < 256; jb += G) { const int job = ((jb & 7) << 5) | (jb >> 3); const int bh = job >> 1, st = job & 1;
#pragma unroll 1
                    for (int u = 0; u < 4; ++u) { const int base = st ? 2 : 0; const int qb = (u & 1) ? base + (u >> 1) : 7 - base - (u >> 1);
                        att::sb_unit(al, QKV, bh >> 4, bh & 15, qb, wave0); } }
            } else {
                const float* lq1 = p.in[9] + (size_t)j * 128; const float* lk1 = p.in[10] + (size_t)j * 128; const float* lq2 = p.in[11] + (size_t)j * 128; const float* lk2 = p.in[12] + (size_t)j * 128;
                const float lam_init = 0.8f - 0.6f * expf(-0.3f * (float)L);
                const float s1 = wave_sum(lq1[lane] * lk1[lane] + lq1[lane + 64] * lk1[lane + 64]), s2 = wave_sum(lq2[lane] * lk2[lane] + lq2[lane + 64] * lk2[lane + 64]);
                const float lam = __uint_as_float(__builtin_amdgcn_readfirstlane(__float_as_uint(expf(s1) - expf(s2) + lam_init)));
                const float* gsub = p.in[13] + (size_t)j * 256;
                float mfix2 = 0.f; bool fixedref = false;
                { const float* gq = p.in[7] + (size_t)j * 128; const float* gk = p.in[8] + (size_t)j * 128;
                  float mq = fmaxf(fabsf(gq[lane]), fabsf(gq[lane + 64])), mk = fmaxf(fabsf(gk[lane]), fabsf(gk[lane + 64]));
#define WMAX_(v, m_) v = fmaxf(v, __int_as_float(__builtin_amdgcn_ds_swizzle(__float_as_int(v), ((m_) << 10) | 0x1F)))
                  WMAX_(mq, 1); WMAX_(mq, 2); WMAX_(mq, 4); WMAX_(mq, 8); WMAX_(mq, 16); WMAX_(mk, 1); WMAX_(mk, 2); WMAX_(mk, 4); WMAX_(mk, 8); WMAX_(mk, 16);
#undef WMAX_
                  { auto r1 = __builtin_amdgcn_permlane32_swap(__float_as_uint(mq), __float_as_uint(mq), false, false); mq = fmaxf(__uint_as_float(r1[0]), __uint_as_float(r1[1]));
                    auto r2 = __builtin_amdgcn_permlane32_swap(__float_as_uint(mk), __float_as_uint(mk), false, false); mk = fmaxf(__uint_as_float(r2[0]), __uint_as_float(r2[1])); }
                  const float bound = __uint_as_float(__builtin_amdgcn_readfirstlane(__float_as_uint(11.313708499f * mq * mk * 1.01f + 0.1f)));
                  fixedref = bound <= 40.0f; mfix2 = -bound * 1.4426950408889634f; }
                for (int jb = blockIdx.x; jb < 256; jb += G) { const int job = ((jb & 7) << 5) | (jb >> 3); const int bh = job >> 2, st = job & 3;
#pragma unroll 1
                    for (int u = 0; u < 4; ++u) { const int qb = (u == 0) ? 15 - st : (u == 1) ? st : (u == 2) ? 8 + st : 7 - st;
                        if (fixedref) att::df_unit<true>(al, QKV, gsub, lam, 1.0f - lam_init, bh >> 3, bh & 7, qb, wave0, mfix2);
                        else att::df_unit<false>(al, QKV, gsub, lam, 1.0f - lam_init, bh >> 3, bh & 7, qb, wave0, 0.f); } }
            }
        } else if (k == 4) {
            pg8::Gemm g{XN, Win_t + (size_t)QKVP * DM, M, EW, DM, DM, wave0}; pg8::StaticOrder S; S.init(M, EW, G, (int)blockIdx.x);
            pg8::EpiGate E{QKV, QKVP};
            pg8::gemm_phase<pg8::EpiGate, pg8::StaticOrder, true, true>(lds, g, S, E);
        } else {
            pg8::Gemm g{QKV, Wout_t, M, DM, EW, QKVP, wave0}; pg8::StaticOrder S; S.init(M, DM, G, (int)blockIdx.x);
            if (fusedn && L + 1 < DEPTH) {
                const int Ln = L + 1, jn = Ln >> 1; const bool dfn = (Ln & 1) != 0;
                const float* nrm_n = (dfn ? p.in[4] : p.in[1]) + (size_t)jn * DM;
                pg8::RowStats st{(unsigned*)(ws + WS_XBUF), (unsigned*)(ws + WS_CNT + (size_t)L * CNT_BANK)};
                pg8::EpiResNorm E{hin, out, DM, XN, nrm_n, st};
                pg8::gemm_phase<pg8::EpiResNorm, pg8::StaticOrder, false, true>(lds, g, S, E);
                __syncthreads();
                PHASE_IDS();
                const float* w_in_n = (dfn ? p.in[5] : p.in[2]) + (size_t)jn * DM * N4;
                const float* w_out_n = (dfn ? p.in[6] : p.in[3]) + (size_t)jn * EW * DM;
                bf16* Wout_n = (bf16*)(ws + ((Ln & 1) ? WS_WOUT2 : WS_WOUT));
                LAS float* scr = (LAS float*)(lds + wave * 16384);
                convert_weights(w_in_n, w_out_n, Win_t, Wout_n, dfn, scr, gw, NGW, lane);
            } else {
                pg8::EpiResidual E{hin, out, DM};
                pg8::gemm_phase<pg8::EpiResidual, pg8::StaticOrder, true, true>(lds, g, S, E);
            }
        }
    }
}

extern "C" void kernel_launch(void* const* d_in, const int* in_sizes, int n_in, void* d_out, int out_size, void* d_ws, size_t ws_size, hipStream_t stream) {
    static int grid = 0;
    if (grid == 0) {
        if (n_in != 14 || in_sizes[0] != M * DM || out_size != M * DM || ws_size < WS_END) { fprintf(stderr, "kernel_launch: unexpected shapes (n_in %d in0 %d out %d ws %zu)\n", n_in, n_in > 0 ? in_sizes[0] : -1, out_size, ws_size); grid = -1; return; }
        int dev = 0, cus = 0, per_cu = 0;
        (void)hipGetDevice(&dev); (void)hipDeviceGetAttribute(&cus, hipDeviceAttributeMultiprocessorCount, dev);
        if (hipFuncSetAttribute((const void*)fwd, hipFuncAttributeMaxDynamicSharedMemorySize, LDS_BYTES) != hipSuccess) { fprintf(stderr, "kernel_launch: hipFuncSetAttribute failed\n"); grid = -1; return; }
        if (hipOccupancyMaxActiveBlocksPerMultiprocessor(&per_cu, (const void*)fwd, NWAVES * 64, LDS_BYTES) != hipSuccess || per_cu < 1) { fprintf(stderr, "kernel_launch: occupancy query gave %d\n", per_cu); per_cu = 1; }
        (void)hipGetLastError();
        if (cus <= 0) cus = 256;
        grid = cus * per_cu; if (grid > 256) grid = 256;
    }
    if (grid < 0) return;
    if (hipMemsetAsync(d_ws, 0, CTL_ZERO_BYTES, stream) != hipSuccess) { fprintf(stderr, "kernel_launch: memset failed\n"); return; }
    Params p{};
    for (int i = 0; i < 14; ++i) p.in[i] = (const float*)d_in[i];
    p.out = (float*)d_out; p.ws = (unsigned char*)d_ws; p.probe = PROBE;
#if MK_MULTI
    for (int id = 0; id < DEPTH * 6; ++id) { if ((id % 6) == 2 && ((id / 6) & 1) == 0) continue;
        p.ph_lo = id; p.ph_hi = id + 1; void* args[] = {&p};
        hipError_t e = hipLaunchCooperativeKernel((const void*)fwd, dim3(grid), dim3(NWAVES * 64), args, LDS_BYTES, stream);
        if (e != hipSuccess) { fprintf(stderr, "launch %d failed: %s\n", id, hipGetErrorString(e)); break; } }
#else
    p.ph_lo = 0; p.ph_hi = DEPTH * 6; void* args[] = {&p};
    hipError_t e = hipLaunchCooperativeKernel((const void*)fwd, dim3(grid), dim3(NWAVES * 64), args, LDS_BYTES, stream);
    if (e != hipSuccess) fprintf(stderr, "cooperative launch failed: %s (grid %d)\n", hipGetErrorString(e), grid);
#endif
}
```

```cpp
#include <hip/hip_runtime.h>
#include <hip/hip_cooperative_groups.h>
#include <cstdio>
#include <cstdint>
namespace cg = cooperative_groups;
__device__ __forceinline__ int my_tid(int wave0) { int l; asm volatile("v_mbcnt_lo_u32_b32 %0, -1, 0\n\tv_mbcnt_hi_u32_b32 %0, -1, %0" : "=&v"(l)); return wave0 * 64 + l; }
template <int MASK> __device__ __forceinline__ float xshfl(float v) {
    if constexpr (MASK == 32) { auto rr = __builtin_amdgcn_permlane32_swap(__float_as_uint(v), __float_as_uint(v), false, false); int l; asm volatile("v_mbcnt_lo_u32_b32 %0, -1, 0" : "=v"(l)); (void)l;
        return __uint_as_float(rr[0]) == v ? __uint_as_float(rr[1]) : __uint_as_float(rr[0]); }
    else return __int_as_float(__builtin_amdgcn_ds_swizzle(__float_as_int(v), (MASK << 10) | 0x1F));
}
template <int MASK> __device__ __forceinline__ float xsum(float v) {
    if constexpr (MASK == 32) { auto rr = __builtin_amdgcn_permlane32_swap(__float_as_uint(v), __float_as_uint(v), false, false); return __uint_as_float(rr[0]) + __uint_as_float(rr[1]); }
    else return v + __int_as_float(__builtin_amdgcn_ds_swizzle(__float_as_int(v), (MASK << 10) | 0x1F));
}
#define PROBE 0
namespace pg8 {
#define PG8_LAS __attribute__((address_space(3)))
typedef unsigned short bf16_t;
typedef short bf16x8 __attribute__((ext_vector_type(8)));
typedef float f32x4 __attribute__((ext_vector_type(4)));
typedef unsigned u32x4 __attribute__((ext_vector_type(4)));
constexpr int BM = 256, BK = 64, HALF = 128, HTB = HALF * BK * 2  , STAGE_BYTES = 8 * HTB, NXCD = 8, WGM = 8;

__host__ __device__ __forceinline__ int lds_byte(int r, int c) { const int st = (r >> 4) * 2 + (c >> 5), rr = r & 15, cc = c & 31, ob = rr * 64 + cc * 2; return st * 1024 + (ob ^ (((ob >> 9) & 1) << 5)); }
__host__ __device__ __forceinline__ void stage_rc(int b, int& R, int& C) { const int st = b / 1024, sb = b % 1024, swz = sb ^ (((sb >> 9) & 1) << 5); R = (st >> 1) * 16 + swz / 64; C = (st & 1) * 32 + (swz % 64) / 2; }
__host__ __device__ __forceinline__ int perm32(int rho) { const int n = rho >> 4, i = rho & 15; return 8 * (i >> 2) + 4 * n + (i & 3); }

struct Unit { int pm, pn; };
struct Gemm { const bf16_t* A; const bf16_t* Bt; int M, N, K, lda, wave; };

struct StaticOrder {
    int nM, nN, nwg, G, c;
    __host__ __device__ void init(int M, int N, int G_, int c_) { nM = M / BM; nN = N / BM; nwg = nM * nN; G = G_; c = c_; }
    __host__ __device__ bool next(int i, Unit& u) const {
        const long L = (long)i * G + c; if (L >= nwg) return false;
        int wgid = (int)L; { const int q = nwg / NXCD, r = nwg % NXCD, xcd = wgid % NXCD, off = wgid / NXCD; wgid = (xcd < r ? xcd * (q + 1) : r * (q + 1) + (xcd - r) * q) + off; }
        const int nig = WGM * nN, gid = wgid / nig, fm = gid * WGM, gsz = (nM - fm) < WGM ? (nM - fm) : WGM;
        u.pm = fm + ((wgid % nig) % gsz); u.pn = (wgid % nig) / gsz; return true;
    }
    __device__ __forceinline__ void a_ready(const Unit&) const {}
    __device__ __forceinline__ void done(const Unit&) const {}
};

__device__ __forceinline__ unsigned cvt_pk_bf16(float lo, float hi) { unsigned r; asm volatile("v_cvt_pk_bf16_f32 %0, %1, %2" : "=v"(r) : "v"(lo), "v"(hi)); return r; }
struct EpiStoreBf16 {
    static constexpr bool PERM = true, AFTER_DRAIN = false;
    bf16_t* O; int ldc; int rope; PG8_LAS float* xl;
    __device__ __forceinline__ void operator()(const f32x4 (&acc)[2][2][4][2], const Unit& u, int wr, int wc, int fr, int fq) const {
        const int row0 = u.pm * BM + wr * 64 + fr;
        if (rope && u.pn < 16) {
#pragma unroll
            for (int ai = 0; ai < 2; ++ai)
#pragma unroll
                for (int m = 0; m < 4; ++m) { float s = 0.f;
#pragma unroll
                    for (int bj = 0; bj < 2; ++bj)
#pragma unroll
                        for (int n = 0; n < 2; ++n) { const f32x4 x = acc[ai][bj][m][n]; s += (x[0] * x[0] + x[1] * x[1]) + (x[2] * x[2] + x[3] * x[3]); }
                    s = xsum<16>(s); s = xsum<32>(s);
                    if (fq == 0) xl[(ai * HALF + wr * 64 + m * 16 + fr) * 4 + wc] = s; }
            asm volatile("s_waitcnt lgkmcnt(0)" ::: "memory"); __builtin_amdgcn_s_barrier(); asm volatile("" ::: "memory");
            const int i0 = 32 * (wc & 1) + 8 * fq;
            const PG8_LAS float* gt = xl + 1024 + (u.pn >= 8 ? 128 : 0);
            const int colo = u.pn * BM + (wc >> 1) * 128 + i0;
#pragma unroll
            for (int ai = 0; ai < 2; ++ai)
#pragma unroll
                for (int m = 0; m < 4; ++m) { const int rloc = ai * HALF + wr * 64 + m * 16 + fr, row = u.pm * BM + rloc;
                    asm volatile("" ::: "memory");
                    int i0o = i0; asm volatile("" : "+v"(i0o));
                    const float rstd = __builtin_amdgcn_rsqf((xl[rloc * 4 + wc] + xl[rloc * 4 + (wc ^ 1)]) * (1.0f / 128.0f) + 1e-6f);
                    const float pos = (float)(row & 2047);
                    u32x4 w1, w2;
#pragma unroll
                    for (int n = 0; n < 2; ++n) { const f32x4 g1 = *(const PG8_LAS f32x4*)(gt + i0o + 4 * n), g2 = *(const PG8_LAS f32x4*)(gt + 64 + i0o + 4 * n);
                        float o1[4], o2[4];
#pragma unroll
                        for (int jj = 0; jj < 4; ++jj) { const float fr_ = __builtin_amdgcn_exp2f(-(float)(i0o + 4 * n + jj) * (13.287712379549449f / 64.0f)) * 0.15915494309189535f;
                            float r = pos * fr_; r -= __builtin_floorf(r); const float c = __builtin_amdgcn_cosf(r), sn = __builtin_amdgcn_sinf(r);
                            const float n1 = acc[ai][0][m][n][jj] * rstd * g1[jj], n2 = acc[ai][1][m][n][jj] * rstd * g2[jj];
                            o1[jj] = n1 * c - n2 * sn; o2[jj] = n2 * c + n1 * sn; }
                        if (n == 0) { w1.x = cvt_pk_bf16(o1[0], o1[1]); w1.y = cvt_pk_bf16(o1[2], o1[3]); w2.x = cvt_pk_bf16(o2[0], o2[1]); w2.y = cvt_pk_bf16(o2[2], o2[3]); }
                        else { w1.z = cvt_pk_bf16(o1[0], o1[1]); w1.w = cvt_pk_bf16(o1[2], o1[3]); w2.z = cvt_pk_bf16(o2[0], o2[1]); w2.w = cvt_pk_bf16(o2[2], o2[3]); } }
                    bf16_t* rowp = O + (size_t)row * ldc + colo;
                    *(u32x4*)rowp = w1; *(u32x4*)(rowp + 64) = w2; }
            return;
        }
        const int col0 = u.pn * BM + wc * 32 + 8 * fq;
#pragma unroll
        for (int ai = 0; ai < 2; ++ai)
#pragma unroll
            for (int m = 0; m < 4; ++m) { bf16_t* rowp = O + (size_t)(row0 + ai * HALF + m * 16) * ldc + col0;
#pragma unroll
                for (int bj = 0; bj < 2; ++bj) { const f32x4 v0 = acc[ai][bj][m][0], v1 = acc[ai][bj][m][1];
                    u32x4 w; w.x = cvt_pk_bf16(v0[0], v0[1]); w.y = cvt_pk_bf16(v0[2], v0[3]); w.z = cvt_pk_bf16(v1[0], v1[1]); w.w = cvt_pk_bf16(v1[2], v1[3]);
                    *(u32x4*)(rowp + bj * HALF) = w; } }
    }
};
__device__ __forceinline__ float silu_f(float z) { return z * __builtin_amdgcn_rcpf(1.0f + __builtin_amdgcn_exp2f(-1.4426950408889634f * z)); }
struct EpiGate {
    static constexpr bool PERM = true, AFTER_DRAIN = false;
    bf16_t* Y; int ldc;
    __device__ __forceinline__ void operator()(const f32x4 (&acc)[2][2][4][2], const Unit& u, int wr, int wc, int fr, int fq) const {
        const int row0 = u.pm * BM + wr * 64 + fr; const int col0 = u.pn * BM + wc * 32 + 8 * fq;
#pragma unroll
        for (int ai = 0; ai < 2; ++ai)
#pragma unroll
            for (int m = 0; m < 4; ++m) { bf16_t* rowp = Y + (size_t)(row0 + ai * HALF + m * 16) * ldc + col0;
#pragma unroll
                for (int bj = 0; bj < 2; ++bj) { const f32x4 v0 = acc[ai][bj][m][0], v1 = acc[ai][bj][m][1];
                    const u32x4 o = *(const u32x4*)(rowp + bj * HALF);
                    u32x4 w;
                    w.x = cvt_pk_bf16(__uint_as_float(o.x << 16) * silu_f(v0[0]), __uint_as_float(o.x & 0xffff0000u) * silu_f(v0[1]));
                    w.y = cvt_pk_bf16(__uint_as_float(o.y << 16) * silu_f(v0[2]), __uint_as_float(o.y & 0xffff0000u) * silu_f(v0[3]));
                    w.z = cvt_pk_bf16(__uint_as_float(o.z << 16) * silu_f(v1[0]), __uint_as_float(o.z & 0xffff0000u) * silu_f(v1[1]));
                    w.w = cvt_pk_bf16(__uint_as_float(o.w << 16) * silu_f(v1[2]), __uint_as_float(o.w & 0xffff0000u) * silu_f(v1[3]));
                    *(u32x4*)(rowp + bj * HALF) = w; } }
    }
};
struct EpiResidual {
    static constexpr bool PERM = false, AFTER_DRAIN = false;
    const float* base; float* out; int ldc;
    __device__ __forceinline__ void operator()(const f32x4 (&acc)[2][2][4][2], const Unit& u, int wr, int wc, int fr, int fq) const {
        const int row0 = u.pm * BM + wr * 64 + fr; const int col0 = u.pn * BM + wc * 32 + 4 * fq;
#pragma unroll
        for (int ai = 0; ai < 2; ++ai)
#pragma unroll
            for (int m = 0; m < 4; ++m) { const size_t off = (size_t)(row0 + ai * HALF + m * 16) * ldc + col0;
#pragma unroll
                for (int bj = 0; bj < 2; ++bj)
#pragma unroll
                    for (int n = 0; n < 2; ++n) { const f32x4 b = *(const f32x4*)(base + off + bj * HALF + n * 16);
                        *(f32x4*)(out + off + bj * HALF + n * 16) = b + acc[ai][bj][m][n]; } }
    }
};

struct RowStats {
    unsigned* xbuf;
    unsigned* cnt;
    __device__ __forceinline__ void run(const f32x4 (&v)[2][2][4][2], const Unit& u, int wr, int wc, int fr, int fq, PG8_LAS unsigned char* lds, int wid, int lane) const {
        PG8_LAS float* P = (PG8_LAS float*)lds;
        PG8_LAS float* S = (PG8_LAS float*)(lds + 8192);
#pragma unroll
        for (int ai = 0; ai < 2; ++ai)
#pragma unroll
            for (int m = 0; m < 4; ++m) { float s = 0.f;
#pragma unroll
                for (int bj = 0; bj < 2; ++bj)
#pragma unroll
                    for (int n = 0; n < 2; ++n) { const f32x4 x = v[ai][bj][m][n]; s += (x[0] * x[0] + x[1] * x[1]) + (x[2] * x[2] + x[3] * x[3]); }
                s = xsum<16>(s); s = xsum<32>(s);
                if (fq == 0) P[(ai * HALF + wr * 64 + m * 16 + fr) * 4 + wc] = s; }
        asm volatile("s_waitcnt lgkmcnt(0)" ::: "memory"); __builtin_amdgcn_s_barrier(); asm volatile("" ::: "memory");
        const int row = wid * 32 + (lane & 31);
        if (lane < 32) { const float s = (P[row * 4 + 0] + P[row * 4 + 1]) + (P[row * 4 + 2] + P[row * 4 + 3]);
            __hip_atomic_store(xbuf + (size_t)(u.pm * BM + row) * 4 + u.pn, __float_as_uint(s), __ATOMIC_RELAXED, __HIP_MEMORY_SCOPE_AGENT); }
        asm volatile("s_waitcnt vmcnt(0)" ::: "memory");
        if (lane == 0) __hip_atomic_fetch_add(cnt + 64 * u.pm, 1u, __ATOMIC_RELAXED, __HIP_MEMORY_SCOPE_AGENT);
        if (wid == 0) {
            unsigned spins = 0;
            while ((unsigned)__builtin_amdgcn_readfirstlane(__hip_atomic_load(cnt + 64 * u.pm, __ATOMIC_RELAXED, __HIP_MEMORY_SCOPE_AGENT)) < 32u) { __builtin_amdgcn_s_sleep(2); if (++spins > (1u << 22)) break; }
            __builtin_amdgcn_fence(__ATOMIC_ACQUIRE, "agent");
        }
        asm volatile("s_waitcnt vmcnt(0) lgkmcnt(0)" ::: "memory"); __builtin_amdgcn_s_barrier(); asm volatile("" ::: "memory");
        if (lane < 32) { unsigned* slot = xbuf + (size_t)(u.pm * BM + row) * 4; float s[4];
#pragma unroll
            for (int t = 0; t < 4; ++t) s[t] = __uint_as_float(__hip_atomic_load(slot + t, __ATOMIC_RELAXED, __HIP_MEMORY_SCOPE_AGENT));
            S[row] = __builtin_amdgcn_rsqf(((s[0] + s[1]) + (s[2] + s[3])) * (1.0f / 1024.0f) + 1e-6f); }
        asm volatile("s_waitcnt lgkmcnt(0)" ::: "memory"); __builtin_amdgcn_s_barrier(); asm volatile("" ::: "memory");
    }
};
struct EpiResNorm {
    static constexpr bool PERM = false, AFTER_DRAIN = true;
    const float* base; float* out; int ldc; bf16_t* xn; const float* g; RowStats st;
    __device__ __forceinline__ void operator()(const f32x4 (&)[2][2][4][2], const Unit&, int, int, int, int) const {}
    __device__ __forceinline__ void fused(f32x4 (&acc)[2][2][4][2], const Unit& u, int wr, int wc, int fr, int fq, PG8_LAS unsigned char* lds, int wid, int lane) const {
        typedef unsigned u32x2v __attribute__((ext_vector_type(2)));
        const PG8_LAS float* S = (const PG8_LAS float*)(lds + 8192);
        const int col0 = u.pn * BM + wc * 32 + 4 * fq;
#pragma unroll
        for (int ai = 0; ai < 2; ++ai)
#pragma unroll
            for (int m = 0; m < 4; ++m) { const size_t off = (size_t)(u.pm * BM + ai * HALF + wr * 64 + m * 16 + fr) * ldc + col0;
#pragma unroll
                for (int bj = 0; bj < 2; ++bj)
#pragma unroll
                    for (int n = 0; n < 2; ++n) acc[ai][bj][m][n] += *(const f32x4*)(base + off + bj * HALF + n * 16);
                asm volatile("" : "+v"(acc[ai][0][m][0]), "+v"(acc[ai][0][m][1]), "+v"(acc[ai][1][m][0]), "+v"(acc[ai][1][m][1]));
                if (m & 1) asm volatile("" ::: "memory"); }
        st.run(acc, u, wr, wc, fr, fq, lds, wid, lane);
        f32x4 gv[2][2];
#pragma unroll
        for (int bj = 0; bj < 2; ++bj)
#pragma unroll
            for (int n = 0; n < 2; ++n) gv[bj][n] = *(const f32x4*)(g + col0 + bj * HALF + n * 16);
#pragma unroll
        for (int ai = 0; ai < 2; ++ai)
#pragma unroll
            for (int m = 0; m < 4; ++m) { const int r = ai * HALF + wr * 64 + m * 16 + fr; const float rs = S[r]; const size_t off = (size_t)(u.pm * BM + r) * ldc + col0;
#pragma unroll
                for (int bj = 0; bj < 2; ++bj)
#pragma unroll
                    for (int n = 0; n < 2; ++n) { const f32x4 x = acc[ai][bj][m][n]; *(f32x4*)(out + off + bj * HALF + n * 16) = x;
                        const f32x4 o = x * rs * gv[bj][n]; u32x2v w; w.x = cvt_pk_bf16(o[0], o[1]); w.y = cvt_pk_bf16(o[2], o[3]);
                        *(u32x2v*)(xn + off + bj * HALF + n * 16) = w; } }
    }
};

template <class Epi, class Sched, bool ALIGN_EPI = false, bool SP2 = false>
__device__ __forceinline__ void gemm_phase(PG8_LAS unsigned char* lds, const Gemm g, const Sched& S, const Epi& E) {
    int tid_o = my_tid(g.wave); asm volatile("" : "+v"(tid_o)); const int tid = tid_o, wid = __builtin_amdgcn_readfirstlane(tid >> 6), lane = tid & 63, wr = wid >> 2, wc = wid & 3, fr = lane & 15, fq = lane >> 4;
    const int K = g.K, nt = K / BK;
    unsigned voffA[2], voffB[2];
#pragma unroll
    for (int i = 0; i < 2; ++i) { int R, C; stage_rc(tid * 16 + i * 8192, R, C); const int Rb = Epi::PERM ? ((R & ~31) + perm32(R & 31)) : R;
        voffA[i] = (unsigned)(R * g.lda + C) * 2u; voffB[i] = (unsigned)(Rb * K + C) * 2u; }
    const size_t kstep = (size_t)(BK * 2);
    const size_t hstep = (size_t)HALF * K * 2;
    const size_t tstep = 2 * hstep; const size_t hstepA = (size_t)HALF * g.lda * 2, tstepA = 2 * hstepA;
    const unsigned ldsw = (unsigned)wid * 1024u;
    const int aoff = lds_byte(wr * 64 + fr, fq * 8), boff = lds_byte(wc * 32 + fr, fq * 8);
#define PG8_SA(b, h) (((b) * 2 + (h)) * HTB)
#define PG8_SB(b, h) ((4 + (b) * 2 + (h)) * HTB)
#define PG8_STAGE(bufoff, gbase, voff) do { _Pragma("unroll") for (int _i = 0; _i < 2; ++_i) \
        __builtin_amdgcn_global_load_lds((const unsigned*)((const char*)(gbase) + (voff)[_i]), (PG8_LAS unsigned*)(lds + (bufoff) + ldsw + _i * 8192), 16, 0, 0); } while (0)
#define PG8_LDA(dst, b, h) do { _Pragma("unroll") for (int m = 0; m < 4; ++m) _Pragma("unroll") for (int k = 0; k < 2; ++k) dst[m][k] = *(const PG8_LAS bf16x8*)(lds + PG8_SA(b, h) + aoff + m * 2048 + k * 1024); } while (0)
#define PG8_LDB(dst, b, h) do { _Pragma("unroll") for (int n = 0; n < 2; ++n) _Pragma("unroll") for (int k = 0; k < 2; ++k) dst[n][k] = *(const PG8_LAS bf16x8*)(lds + PG8_SB(b, h) + boff + n * 2048 + k * 1024); } while (0)
#define PG8_MMA(ai, bj, At, Bt) do { __builtin_amdgcn_s_setprio(1); _Pragma("unroll") for (int m = 0; m < 4; ++m) _Pragma("unroll") for (int n = 0; n < 2; ++n) _Pragma("unroll") for (int k = 0; k < 2; ++k) \
        acc[ai][bj][m][n] = __builtin_amdgcn_mfma_f32_16x16x32_bf16(Bt[n][k], At[m][k], acc[ai][bj][m][n], 0, 0, 0); __builtin_amdgcn_s_setprio(0); } while (0)
#define PG8_WAIT_V(n) asm volatile("s_waitcnt vmcnt(" #n ")" ::: "memory")
#define PG8_WAIT_L(n) asm volatile("s_waitcnt lgkmcnt(" #n ")" ::: "memory")
#define PG8_BAR __builtin_amdgcn_s_barrier()
#define PG8_SCHED __builtin_amdgcn_sched_barrier(0)
    Unit cur, nxt; int ui = 0;
    if (!S.next(0, cur)) return;
    f32x4 acc[2][2][4][2];
#pragma unroll
    for (int a = 0; a < 2; ++a)
#pragma unroll
        for (int b = 0; b < 2; ++b)
#pragma unroll
            for (int m = 0; m < 4; ++m)
#pragma unroll
                for (int n = 0; n < 2; ++n) acc[a][b][m][n] = (f32x4){0.f, 0.f, 0.f, 0.f};
    bf16x8 At[4][2], B0[2][2], B1[2][2];
    const char* cA = (const char*)g.A + (size_t)cur.pm * tstepA; const char* cB = (const char*)g.Bt + (size_t)cur.pn * tstep;
    S.a_ready(cur);
    if constexpr (SP2) {
        PG8_STAGE(PG8_SB(0, 0), cB, voffB); PG8_STAGE(PG8_SB(0, 1), cB + hstep, voffB); PG8_STAGE(PG8_SA(0, 0), cA, voffA); PG8_STAGE(PG8_SA(0, 1), cA + hstepA, voffA);
        if (wr == 1) PG8_BAR;
        PG8_WAIT_V(2); PG8_BAR;
        PG8_STAGE(PG8_SB(1, 0), cB + kstep, voffB); PG8_STAGE(PG8_SA(1, 0), cA + kstep, voffA); PG8_STAGE(PG8_SB(1, 1), cB + hstep + kstep, voffB);
        PG8_WAIT_V(6); PG8_BAR;
    } else {
        PG8_STAGE(PG8_SB(0, 0), cB, voffB); PG8_STAGE(PG8_SA(0, 0), cA, voffA); PG8_STAGE(PG8_SB(0, 1), cB + hstep, voffB); PG8_STAGE(PG8_SA(0, 1), cA + hstepA, voffA);
        if (wr == 1) PG8_BAR;
        PG8_WAIT_V(4); PG8_BAR;
        PG8_STAGE(PG8_SB(1, 0), cB + kstep, voffB); PG8_STAGE(PG8_SA(1, 0), cA + kstep, voffA); PG8_STAGE(PG8_SB(1, 1), cB + hstep + kstep, voffB);
        PG8_WAIT_V(6); PG8_BAR;
    }
    for (;;) {
        const bool has_next = S.next(ui + 1, nxt);
        const char* nA = has_next ? (const char*)g.A + (size_t)nxt.pm * tstepA : cA; const char* nB = has_next ? (const char*)g.Bt + (size_t)nxt.pn * tstep : cB;
        for (int t = 0; t < nt; t += 2) {
            const bool last = (t == nt - 2);
            const char* a1 = cA + (size_t)(t + 1) * kstep;
            const char* a2 = last ? nA : cA + (size_t)(t + 2) * kstep; const char* b2 = last ? nB : cB + (size_t)(t + 2) * kstep;
            const char* a3 = a2 + kstep; const char* b3 = b2 + kstep;
            if (last && has_next) S.a_ready(nxt);
            if constexpr (SP2) {
            PG8_LDB(B0, 0, 0); PG8_LDB(B1, 0, 1); PG8_SCHED; PG8_LDA(At, 0, 0); PG8_STAGE(PG8_SA(1, 1), a1 + hstepA, voffA);
            PG8_WAIT_V(8); PG8_WAIT_L(0); PG8_BAR; PG8_MMA(0, 0, At, B0); PG8_MMA(0, 1, At, B1); PG8_BAR; PG8_SCHED;
            PG8_LDA(At, 0, 1); PG8_STAGE(PG8_SB(0, 0), b2, voffB); PG8_STAGE(PG8_SB(0, 1), b2 + hstep, voffB); PG8_STAGE(PG8_SA(0, 0), a2, voffA);
            PG8_WAIT_V(8); PG8_WAIT_L(0); PG8_BAR; PG8_MMA(1, 0, At, B0); PG8_MMA(1, 1, At, B1); PG8_BAR; PG8_SCHED;
            PG8_LDB(B0, 1, 0); PG8_LDB(B1, 1, 1); PG8_SCHED; PG8_LDA(At, 1, 0); PG8_STAGE(PG8_SA(0, 1), a2 + hstepA, voffA);
            PG8_WAIT_V(8); PG8_WAIT_L(0); PG8_BAR; PG8_MMA(0, 0, At, B0); PG8_MMA(0, 1, At, B1); PG8_BAR; PG8_SCHED;
            PG8_LDA(At, 1, 1); PG8_STAGE(PG8_SB(1, 0), b3, voffB); PG8_STAGE(PG8_SB(1, 1), b3 + hstep, voffB); PG8_STAGE(PG8_SA(1, 0), a3, voffA);
            PG8_WAIT_V(8); PG8_WAIT_L(0); PG8_BAR; PG8_MMA(1, 0, At, B0); PG8_MMA(1, 1, At, B1); PG8_BAR; PG8_SCHED;
            } else {
            PG8_LDB(B0, 0, 0); PG8_SCHED; PG8_LDA(At, 0, 0); PG8_STAGE(PG8_SA(1, 1), a1 + hstepA, voffA);
            PG8_WAIT_L(8); PG8_BAR; PG8_WAIT_L(0); PG8_MMA(0, 0, At, B0); PG8_BAR; PG8_SCHED;
            PG8_LDB(B1, 0, 1); PG8_STAGE(PG8_SB(0, 0), b2, voffB);
            PG8_BAR; PG8_WAIT_L(0); PG8_MMA(0, 1, At, B1); PG8_BAR;
            PG8_LDA(At, 0, 1); PG8_STAGE(PG8_SA(0, 0), a2, voffA);
            PG8_BAR; PG8_WAIT_L(0); PG8_MMA(1, 0, At, B0); PG8_BAR; PG8_SCHED;
            PG8_STAGE(PG8_SB(0, 1), b2 + hstep, voffB);
            PG8_WAIT_V(6); PG8_BAR; PG8_MMA(1, 1, At, B1); PG8_BAR;
            PG8_LDB(B0, 1, 0); PG8_SCHED; PG8_LDA(At, 1, 0); PG8_STAGE(PG8_SA(0, 1), a2 + hstepA, voffA);
            PG8_WAIT_L(8); PG8_BAR; PG8_WAIT_L(0); PG8_MMA(0, 0, At, B0); PG8_BAR; PG8_SCHED;
            PG8_LDB(B1, 1, 1); PG8_STAGE(PG8_SB(1, 0), b3, voffB);
            PG8_BAR; PG8_WAIT_L(0); PG8_MMA(0, 1, At, B1); PG8_BAR;
            PG8_LDA(At, 1, 1); PG8_STAGE(PG8_SA(1, 0), a3, voffA);
            PG8_BAR; PG8_WAIT_L(0); PG8_MMA(1, 0, At, B0); PG8_BAR; PG8_SCHED;
            PG8_STAGE(PG8_SB(1, 1), b3 + hstep, voffB);
            PG8_WAIT_V(6); PG8_BAR; PG8_MMA(1, 1, At, B1); PG8_BAR;
            }
        }
        if constexpr (ALIGN_EPI) { if (wr == 0) PG8_BAR; }
        if constexpr (!Epi::AFTER_DRAIN) { E(acc, cur, wr, wc, fr, fq); S.done(cur); }
        if (!has_next) break;
#pragma unroll
        for (int a = 0; a < 2; ++a)
#pragma unroll
            for (int b = 0; b < 2; ++b)
#pragma unroll
                for (int m = 0; m < 4; ++m)
#pragma unroll
                    for (int n = 0; n < 2; ++n) acc[a][b][m][n] = (f32x4){0.f, 0.f, 0.f, 0.f};
        cur = nxt; cA = nA; cB = nB; ++ui;
        if constexpr (ALIGN_EPI) { if (wr == 1) PG8_BAR; }
    }
    PG8_WAIT_V(0);
    if constexpr (!ALIGN_EPI) { if (wr == 0) PG8_BAR; }
    PG8_BAR;
    if constexpr (Epi::AFTER_DRAIN) { E.fused(acc, cur, wr, wc, fr, fq, lds, wid, lane); S.done(cur); }
#undef PG8_SA
#undef PG8_SB
#undef PG8_STAGE
#undef PG8_LDA
#undef PG8_LDB
#undef PG8_MMA
#undef PG8_WAIT_V
#undef PG8_WAIT_L
#undef PG8_BAR
#undef PG8_SCHED
}
}

namespace att {
#define LAS __attribute__((address_space(3)))
typedef unsigned short bf16_t;
typedef short bf16x8 __attribute__((ext_vector_type(8)));
typedef short s16x4 __attribute__((ext_vector_type(4)));
typedef float f32x16 __attribute__((ext_vector_type(16)));
typedef float f32x4 __attribute__((ext_vector_type(4)));
typedef unsigned u32x4 __attribute__((ext_vector_type(4)));
constexpr int SEQ = 2048, PITCH = 6144, TILE = 16384, SCR_OFF = 131072;
constexpr float SCALE = 0.08838834764831845f, LOG2E = 1.4426950408889634f, EPS = 1e-6f;
#define SBAR() __builtin_amdgcn_sched_barrier(0)
#define VMW() asm volatile("s_waitcnt vmcnt(0)" ::: "memory")
#define GLDS(gptr, ldsptr) __builtin_amdgcn_global_load_lds((const unsigned*)(gptr), (LAS unsigned*)(ldsptr), 16, 0, 0)

__device__ __forceinline__ int crow(int r, int hi) { return (r & 3) + 8 * (r >> 2) + 4 * hi; }
__device__ __forceinline__ unsigned cvtpk(float lo, float hi) { unsigned r; asm volatile("v_cvt_pk_bf16_f32 %0, %1, %2" : "=v"(r) : "v"(lo), "v"(hi)); return r; }
__device__ __forceinline__ int swap23(int k) { return (k & ~0xC) | ((k & 4) << 1) | ((k & 8) >> 1); }
__device__ __forceinline__ unsigned kfmt_goff(int b) { const int row = b >> 8, cp = (b & 255) >> 4, ch = cp ^ (row & 7); return (unsigned)(row * PITCH + ch * 8); }
__device__ __forceinline__ unsigned vfmt_goff(int b) { const int sub = b >> 9, kkhi = sub >> 2, cblk = sub & 3, within = (b & 511) >> 1, kklo = within >> 5, cc = within & 31;
    const int k = swap23(kkhi * 8 + kklo); return (unsigned)(k * PITCH + cblk * 32 + cc); }
__device__ __forceinline__ int v_rd_base(int lane) { return ((lane & 3) << 3) | (((lane >> 2) & 3) << 6) | (((lane >> 4) & 1) << 5) | (((lane >> 5) & 1) << 8); }
#define KSWZ(row, colB) ((row) * 256 + ((colB) ^ (((row) & 7) << 4)))

__device__ __forceinline__ void qkt(f32x16& p0, f32x16& p1, const LAS char* Kt, int r32, int hi, const bf16x8* qr) {
    p0 = f32x16{}; p1 = f32x16{};
    const LAS char* kb[4];
#pragma unroll
    for (int dd = 0; dd < 4; ++dd) kb[dd] = Kt + KSWZ(r32, (dd * 16 + hi * 8) * 2);
#pragma unroll
    for (int d0 = 0; d0 < 8; ++d0) { const LAS char* a = kb[d0 & 3] + (d0 >> 2) * 128;
        const bf16x8 b0 = *reinterpret_cast<const LAS bf16x8*>(a);
        const bf16x8 b1 = *reinterpret_cast<const LAS bf16x8*>(a + 32 * 256);
        p0 = __builtin_amdgcn_mfma_f32_32x32x16_bf16(b0, qr[d0], p0, 0, 0, 0);
        p1 = __builtin_amdgcn_mfma_f32_32x32x16_bf16(b1, qr[d0], p1, 0, 0, 0); }
}
template <bool ALL16>
__device__ __forceinline__ void qkt_b(f32x16& p0, f32x16& p1, unsigned kt, int r32, int hi, const bf16x8* qr) {
    unsigned kb0 = kt + KSWZ(r32, (0 * 16 + hi * 8) * 2), kb1 = kt + KSWZ(r32, (1 * 16 + hi * 8) * 2), kb2 = kt + KSWZ(r32, (2 * 16 + hi * 8) * 2), kb3 = kt + KSWZ(r32, (3 * 16 + hi * 8) * 2);
#define KRD(dst, base, off) asm volatile("ds_read_b128 %0, %1 offset:%2" : "=&v"(dst) : "v"(base), "i"(off) : "memory")
#define KRD8(a, o_) do { KRD(a##0, kb0, (o_)); KRD(a##1, kb1, (o_)); KRD(a##2, kb2, (o_)); KRD(a##3, kb3, (o_)); KRD(a##4, kb0, (o_) + 128); KRD(a##5, kb1, (o_) + 128); KRD(a##6, kb2, (o_) + 128); KRD(a##7, kb3, (o_) + 128); } while (0)
#define KMMA8(p, a) do { p = __builtin_amdgcn_mfma_f32_32x32x16_bf16(a##0, qr[0], p, 0, 0, 0); p = __builtin_amdgcn_mfma_f32_32x32x16_bf16(a##1, qr[1], p, 0, 0, 0); \
        p = __builtin_amdgcn_mfma_f32_32x32x16_bf16(a##2, qr[2], p, 0, 0, 0); p = __builtin_amdgcn_mfma_f32_32x32x16_bf16(a##3, qr[3], p, 0, 0, 0); \
        p = __builtin_amdgcn_mfma_f32_32x32x16_bf16(a##4, qr[4], p, 0, 0, 0); p = __builtin_amdgcn_mfma_f32_32x32x16_bf16(a##5, qr[5], p, 0, 0, 0); \
        p = __builtin_amdgcn_mfma_f32_32x32x16_bf16(a##6, qr[6], p, 0, 0, 0); p = __builtin_amdgcn_mfma_f32_32x32x16_bf16(a##7, qr[7], p, 0, 0, 0); } while (0)
    bf16x8 a0, a1, a2, a3, a4, a5, a6, a7;
    p0 = f32x16{}; p1 = f32x16{};
    if constexpr (ALL16) {
        bf16x8 c0, c1, c2, c3, c4, c5, c6, c7;
        KRD8(a, 0); KRD8(c, 8192);
        asm volatile("s_waitcnt lgkmcnt(8)" ::: "memory"); SBAR();
        KMMA8(p0, a);
        asm volatile("s_waitcnt lgkmcnt(0)" ::: "memory"); SBAR();
        KMMA8(p1, c);
    } else {
        KRD8(a, 0);
        asm volatile("s_waitcnt lgkmcnt(0)" ::: "memory"); SBAR();
        KMMA8(p0, a);
        SBAR();
        KRD8(a, 8192);
        asm volatile("s_waitcnt lgkmcnt(0)" ::: "memory"); SBAR();
        KMMA8(p1, a);
    }
#undef KRD
#undef KRD8
#undef KMMA8
}
template <int ND0>
__device__ __forceinline__ void pv_tile(f32x16* o, unsigned vb, bf16x8 pa0, bf16x8 pa1, bf16x8 pa2, bf16x8 pa3) {
#define TRRD(dst, off) asm volatile("ds_read_b64_tr_b16 %0, %1 offset:%2" : "=&v"(dst) : "v"(vb), "i"(off) : "memory")
#define PV_D0(d0) do { s16x4 l0, l1, l2, l3, h0, h1, h2, h3; constexpr int b_ = ((d0) >> 2) * TILE + ((d0) & 3) * 512; \
        TRRD(l0, b_); TRRD(h0, b_ + 2048); TRRD(l1, b_ + 4096); TRRD(h1, b_ + 6144); TRRD(l2, b_ + 8192); TRRD(h2, b_ + 10240); TRRD(l3, b_ + 12288); TRRD(h3, b_ + 14336); \
        asm volatile("s_waitcnt lgkmcnt(0)" ::: "memory"); SBAR(); \
        o[d0] = __builtin_amdgcn_mfma_f32_32x32x16_bf16(pa0, (bf16x8){l0[0], l0[1], l0[2], l0[3], h0[0], h0[1], h0[2], h0[3]}, o[d0], 0, 0, 0); \
        o[d0] = __builtin_amdgcn_mfma_f32_32x32x16_bf16(pa1, (bf16x8){l1[0], l1[1], l1[2], l1[3], h1[0], h1[1], h1[2], h1[3]}, o[d0], 0, 0, 0); \
        o[d0] = __builtin_amdgcn_mfma_f32_32x32x16_bf16(pa2, (bf16x8){l2[0], l2[1], l2[2], l2[3], h2[0], h2[1], h2[2], h2[3]}, o[d0], 0, 0, 0); \
        o[d0] = __builtin_amdgcn_mfma_f32_32x32x16_bf16(pa3, (bf16x8){l3[0], l3[1], l3[2], l3[3], h3[0], h3[1], h3[2], h3[3]}, o[d0], 0, 0, 0); } while (0)
    PV_D0(0); PV_D0(1); PV_D0(2); PV_D0(3);
    if constexpr (ND0 > 4) { PV_D0(4); PV_D0(5); PV_D0(6); PV_D0(7); }
#undef PV_D0
#undef TRRD
}
template <int ND0>
__device__ __forceinline__ void pv_tile2(f32x16* o, unsigned vb, bf16x8 pa0, bf16x8 pa1, bf16x8 pa2, bf16x8 pa3) {
#define TRRD(dst, off) asm volatile("ds_read_b64_tr_b16 %0, %1 offset:%2" : "=&v"(dst) : "v"(vb), "i"(off) : "memory")
#define PV_OFF(d0) (((d0) >> 2) * TILE + ((d0) & 3) * 512)
#define PV_RD(S, d0) do { constexpr int b_ = PV_OFF(d0); TRRD(S##l0, b_); TRRD(S##h0, b_ + 2048); TRRD(S##l1, b_ + 4096); TRRD(S##h1, b_ + 6144); TRRD(S##l2, b_ + 8192); TRRD(S##h2, b_ + 10240); TRRD(S##l3, b_ + 12288); TRRD(S##h3, b_ + 14336); } while (0)
#define PV_MM(S, d0) do { \
        o[d0] = __builtin_amdgcn_mfma_f32_32x32x16_bf16(pa0, (bf16x8){S##l0[0], S##l0[1], S##l0[2], S##l0[3], S##h0[0], S##h0[1], S##h0[2], S##h0[3]}, o[d0], 0, 0, 0); \
        o[d0] = __builtin_amdgcn_mfma_f32_32x32x16_bf16(pa1, (bf16x8){S##l1[0], S##l1[1], S##l1[2], S##l1[3], S##h1[0], S##h1[1], S##h1[2], S##h1[3]}, o[d0], 0, 0, 0); \
        o[d0] = __builtin_amdgcn_mfma_f32_32x32x16_bf16(pa2, (bf16x8){S##l2[0], S##l2[1], S##l2[2], S##l2[3], S##h2[0], S##h2[1], S##h2[2], S##h2[3]}, o[d0], 0, 0, 0); \
        o[d0] = __builtin_amdgcn_mfma_f32_32x32x16_bf16(pa3, (bf16x8){S##l3[0], S##l3[1], S##l3[2], S##l3[3], S##h3[0], S##h3[1], S##h3[2], S##h3[3]}, o[d0], 0, 0, 0); } while (0)
#define PV_W8() do { asm volatile("s_waitcnt lgkmcnt(8)" ::: "memory"); SBAR(); } while (0)
#define PV_W0() do { asm volatile("s_waitcnt lgkmcnt(0)" ::: "memory"); SBAR(); } while (0)
    s16x4 Al0, Al1, Al2, Al3, Ah0, Ah1, Ah2, Ah3, Bl0, Bl1, Bl2, Bl3, Bh0, Bh1, Bh2, Bh3;
    PV_RD(A, 0);
    PV_RD(B, 1); PV_W8(); PV_MM(A, 0); SBAR();
    PV_RD(A, 2); PV_W8(); PV_MM(B, 1); SBAR();
    if constexpr (ND0 > 4) {
        PV_RD(B, 3); PV_W8(); PV_MM(A, 2); SBAR();
        PV_RD(A, 4); PV_W8(); PV_MM(B, 3); SBAR();
        PV_RD(B, 5); PV_W8(); PV_MM(A, 4); SBAR();
        PV_RD(A, 6); PV_W8(); PV_MM(B, 5); SBAR();
        PV_RD(B, 7); PV_W8(); PV_MM(A, 6); SBAR();
        PV_W0(); PV_MM(B, 7);
    } else {
        PV_RD(B, 3); PV_W8(); PV_MM(A, 2); SBAR();
        PV_W0(); PV_MM(B, 3);
    }
#undef PV_W0
#undef PV_W8
#undef PV_MM
#undef PV_RD
#undef PV_OFF
#undef TRRD
}
#define PK4(P, B_, OUT) do { const unsigned a0 = cvtpk(P[B_+0], P[B_+1]), a1 = cvtpk(P[B_+2], P[B_+3]); \
        const unsigned b0 = cvtpk(P[B_+4], P[B_+5]), b1 = cvtpk(P[B_+6], P[B_+7]); \
        auto r0 = __builtin_amdgcn_permlane32_swap(a0, b0, false, false); auto r1 = __builtin_amdgcn_permlane32_swap(a1, b1, false, false); \
        u32x4 w = {r0[0], r1[0], r0[1], r1[1]}; OUT = *reinterpret_cast<bf16x8*>(&w); } while (0)

__device__ __forceinline__ void sb_tile(f32x16& p0, f32x16& p1, float& carry, int dq, bool need_mask, int hi, bf16x8& pa0, bf16x8& pa1, bf16x8& pa2, bf16x8& pa3) {
    constexpr float C2 = SCALE * LOG2E;
    const float NEG = -__builtin_inff();
    f32x16 l0, l1;
#pragma unroll
    for (int r = 0; r < 16; ++r) {
        { const float z = p0[r] * C2; p0[r] = z; const float t = __builtin_amdgcn_exp2f(-__builtin_fabsf(z)); l0[r] = -(fmaxf(z, 0.f) + __builtin_amdgcn_logf(1.0f + t)); }
        { const float z = p1[r] * C2; p1[r] = z; const float t = __builtin_amdgcn_exp2f(-__builtin_fabsf(z)); l1[r] = -(fmaxf(z, 0.f) + __builtin_amdgcn_logf(1.0f + t)); }
    }
    if (need_mask) {
#pragma unroll
        for (int r = 0; r < 16; ++r) { const int c = (r & 3) + 8 * (r >> 2);
            if (dq - c <= 0) { l0[r] = 0.f; p0[r] = NEG; }
            if (dq - c - 32 <= 0) { l1[r] = 0.f; p1[r] = NEG; } }
    }
    float gs[8];
#pragma unroll
    for (int g = 0; g < 4; ++g) { gs[g] = (l0[4 * g] + l0[4 * g + 1]) + (l0[4 * g + 2] + l0[4 * g + 3]); gs[4 + g] = (l1[4 * g] + l1[4 * g + 1]) + (l1[4 * g + 2] + l1[4 * g + 3]); }
    float T = carry, off[8];
#pragma unroll
    for (int i = 7; i >= 0; --i) { auto rr = __builtin_amdgcn_permlane32_swap(__float_as_uint(gs[i]), __float_as_uint(gs[i]), false, false);
        const float a = __uint_as_float(rr[0]), b = __uint_as_float(rr[1]);
        off[i] = hi ? T : T + b; T = T + (a + b); }
    carry = T;
#pragma unroll
    for (int g = 0; g < 4; ++g) {
        { float G = off[g] + l0[4 * g + 3]; p0[4 * g + 3] = __builtin_amdgcn_exp2f(p0[4 * g + 3] + G); G += l0[4 * g + 2]; p0[4 * g + 2] = __builtin_amdgcn_exp2f(p0[4 * g + 2] + G);
          G += l0[4 * g + 1]; p0[4 * g + 1] = __builtin_amdgcn_exp2f(p0[4 * g + 1] + G); G += l0[4 * g]; p0[4 * g] = __builtin_amdgcn_exp2f(p0[4 * g] + G); }
        { float G = off[4 + g] + l1[4 * g + 3]; p1[4 * g + 3] = __builtin_amdgcn_exp2f(p1[4 * g + 3] + G); G += l1[4 * g + 2]; p1[4 * g + 2] = __builtin_amdgcn_exp2f(p1[4 * g + 2] + G);
          G += l1[4 * g + 1]; p1[4 * g + 1] = __builtin_amdgcn_exp2f(p1[4 * g + 1] + G); G += l1[4 * g]; p1[4 * g] = __builtin_amdgcn_exp2f(p1[4 * g] + G); }
    }
    PK4(p0, 0, pa0); PK4(p0, 8, pa1); PK4(p1, 0, pa2); PK4(p1, 8, pa3);
}

constexpr float THR = 8.f;
__device__ __forceinline__ void mask_incl(f32x16& p0, f32x16& p1, int dq) {
    const float NEG = -__builtin_inff();
#pragma unroll
    for (int r = 0; r < 16; ++r) { const int c = (r & 3) + 8 * (r >> 2);
        if (dq - c < 0) p0[r] = NEG;
        if (dq - c - 32 < 0) p1[r] = NEG; }
}
__device__ __forceinline__ void partialSM(f32x16& p0, f32x16& p1, float& m_reg, float& alpha) {
    float pmax = p0[0];
#pragma unroll
    for (int r = 1; r < 16; ++r) pmax = fmaxf(pmax, p0[r]);
#pragma unroll
    for (int r = 0; r < 16; ++r) pmax = fmaxf(pmax, p1[r]);
    { auto rr = __builtin_amdgcn_permlane32_swap(__float_as_uint(pmax), __float_as_uint(pmax), false, false);
      pmax = fmaxf(__uint_as_float(rr[0]), __uint_as_float(rr[1])); }
    constexpr float C2 = LOG2E * SCALE;
    float mn;
    if (__builtin_expect(__all((pmax - m_reg) * SCALE <= THR), 1)) { mn = m_reg; alpha = 1.f; }
    else { mn = fmaxf(m_reg, pmax); alpha = __builtin_amdgcn_exp2f((m_reg - mn) * C2); m_reg = mn; }
    const float mnL = -mn * C2;
#pragma unroll
    for (int r = 0; r < 16; ++r) { p0[r] = __builtin_amdgcn_exp2f(fmaf(p0[r], C2, mnL)); p1[r] = __builtin_amdgcn_exp2f(fmaf(p1[r], C2, mnL)); }
}
__device__ __forceinline__ void finishSM(f32x16& p0, f32x16& p1, float alpha, float& l_reg, bf16x8& pa0, bf16x8& pa1, bf16x8& pa2, bf16x8& pa3) {
    float ps = 0;
#pragma unroll
    for (int r = 0; r < 16; ++r) ps += p0[r];
#pragma unroll
    for (int r = 0; r < 16; ++r) ps += p1[r];
    { auto rr = __builtin_amdgcn_permlane32_swap(__float_as_uint(ps), __float_as_uint(ps), false, false);
      ps = __uint_as_float(rr[0]) + __uint_as_float(rr[1]); }
    l_reg = l_reg * alpha + ps;
    PK4(p0, 0, pa0); PK4(p0, 8, pa1); PK4(p1, 0, pa2); PK4(p1, 8, pa3);
}

__device__ __forceinline__ void sb_unit(LAS char* lds, bf16_t* QKV, int b, int h, int qb, int wave0) {
    int tid_o = my_tid(wave0); asm volatile("" : "+v"(tid_o)); const int tid = tid_o, wid = __builtin_amdgcn_readfirstlane(tid >> 6), lane = tid & 63, r32 = lane & 31, hi = lane >> 5;
    const int P0 = qb * 256, qlo = P0 + wid * 32, qm = qlo + r32 - 4 * hi;
    const unsigned kg0 = kfmt_goff(wid * 1024 + lane * 16), kg1 = kfmt_goff((wid + 8) * 1024 + lane * 16);
    const unsigned vg0 = vfmt_goff(wid * 1024 + lane * 16), vg1 = vfmt_goff((wid + 8) * 1024 + lane * 16);
    bf16_t* rowsq = QKV + (size_t)(b * SEQ + qlo) * PITCH + h * 128;
    bf16x8 qr[8];
#pragma unroll
    for (int d0 = 0; d0 < 8; ++d0) qr[d0] = *reinterpret_cast<const bf16x8*>(rowsq + (size_t)r32 * PITCH + d0 * 16 + hi * 8);
    const bf16_t* Kg = QKV + (size_t)(b * SEQ) * PITCH + 2048 + h * 128;
    const bf16_t* Vg = QKV + (size_t)(b * SEQ) * PITCH + 4096 + h * 128;
    const int NT = 4 * qb + 4;
    const unsigned vbase = (unsigned)(size_t)(lds) + (unsigned)v_rd_base(lane);
#define SB_STAGE(t, bf) do { const size_t ro_ = (size_t)(t) * 64 * PITCH; LAS char* d_ = lds + (bf) * 2 * TILE; \
        GLDS(Kg + ro_ + kg0, d_ + wid * 1024); GLDS(Kg + ro_ + kg1, d_ + (wid + 8) * 1024); \
        GLDS(Vg + ro_ + vg0, d_ + TILE + wid * 1024); GLDS(Vg + ro_ + vg1, d_ + TILE + (wid + 8) * 1024); } while (0)
    f32x16 o[4] = {}; float carry = 0.f;
    LAS unsigned* dflag = (LAS unsigned*)(lds + SCR_OFF);
    bool fin = false;
    SB_STAGE(NT - 1, 0); VMW(); __syncthreads();
    for (int it = 0; it < NT; ++it) {
        const int t = NT - 1 - it, bf = it & 1, kb = t * 64;
        if (it + 1 < NT) SB_STAGE(t - 1, bf ^ 1);
        if (kb < qlo + 31 && !fin) {
            f32x16 p0, p1; bf16x8 pa0, pa1, pa2, pa3;
            qkt_b<true>(p0, p1, (unsigned)(size_t)(lds + bf * 2 * TILE), r32, hi, qr);
            sb_tile(p0, p1, carry, qm - kb, kb + 63 >= qlo, hi, pa0, pa1, pa2, pa3);
            pv_tile2<4>(o, vbase + bf * 2 * TILE + TILE, pa0, pa1, pa2, pa3);
            fin = __all(carry < -134.0f);
        }
        if (lane == 0) dflag[bf * 8 + wid] = fin ? 1u : 0u;
        VMW(); __syncthreads();
        if (__all(dflag[bf * 8 + (lane & 7)] != 0u)) break;
    }
#undef SB_STAGE
#pragma unroll
    for (int r = 0; r < 16; ++r) { const int orow = crow(r, hi);
#pragma unroll
        for (int d0 = 0; d0 < 4; ++d0) *(unsigned short*)(rowsq + (size_t)orow * PITCH + d0 * 32 + r32) = (unsigned short)cvtpk(o[d0][r], 0.f); }
}

template <bool FIXED>
__device__ __forceinline__ void df_unit(LAS char* lds, bf16_t* QKV, const float* gsub, float lam, float post, int b, int h, int qb, int wave0, float mfix2) {
    int tid_o = my_tid(wave0); asm volatile("" : "+v"(tid_o)); const int tid = tid_o, wid = __builtin_amdgcn_readfirstlane(tid >> 6), lane = tid & 63, r32 = lane & 31, hi = lane >> 5;
    const int mp = wid >> 2, wq = wid & 3;
    const int P0 = qb * 128, qlo = P0 + wq * 32, qm = qlo + r32 - 4 * hi;
    const unsigned kg0 = kfmt_goff(wid * 1024 + lane * 16), kg1 = kfmt_goff((wid + 8) * 1024 + lane * 16);
    const unsigned vg0 = vfmt_goff(wid * 1024 + lane * 16), vg1 = vfmt_goff((wid + 8) * 1024 + lane * 16);
    bf16_t* rowsq = QKV + (size_t)(b * SEQ + qlo) * PITCH + h * 256;
    bf16x8 qr[8];
#pragma unroll
    for (int d0 = 0; d0 < 8; ++d0) qr[d0] = *reinterpret_cast<const bf16x8*>(rowsq + (size_t)r32 * PITCH + mp * 128 + d0 * 16 + hi * 8);
    const bf16_t* Kg = QKV + (size_t)(b * SEQ) * PITCH + 2048 + h * 256;
    const bf16_t* Vg = QKV + (size_t)(b * SEQ) * PITCH + 4096 + h * 256;
    const int NT = 2 * qb + 2;
    const unsigned vbase = (unsigned)(size_t)(lds) + (unsigned)v_rd_base(lane);
    LAS float* wsf = (LAS float*)(lds + SCR_OFF) + wid * 64; LAS float* li_l = wsf; LAS float* al_l = wsf + 32;
#define DF_STAGE(t, bf) do { const size_t ro_ = (size_t)(t) * 64 * PITCH; LAS char* d_ = lds + (bf) * 4 * TILE; \
        GLDS(Kg + ro_ + kg0, d_ + wid * 1024); GLDS(Kg + ro_ + kg1, d_ + (wid + 8) * 1024); \
        GLDS(Kg + 128 + ro_ + kg0, d_ + TILE + wid * 1024); GLDS(Kg + 128 + ro_ + kg1, d_ + TILE + (wid + 8) * 1024); \
        GLDS(Vg + ro_ + vg0, d_ + 2 * TILE + wid * 1024); GLDS(Vg + ro_ + vg1, d_ + 2 * TILE + (wid + 8) * 1024); \
        GLDS(Vg + 128 + ro_ + vg0, d_ + 3 * TILE + wid * 1024); GLDS(Vg + 128 + ro_ + vg1, d_ + 3 * TILE + (wid + 8) * 1024); } while (0)
    f32x16 o[8] = {}; float m_reg = -1e30f, l_reg = 0.f;
    DF_STAGE(0, 0); VMW(); __syncthreads();
    for (int t = 0; t < NT; ++t) {
        const int bf = t & 1, kb = t * 64;
        if (t + 1 < NT) DF_STAGE(t + 1, bf ^ 1);
        if (kb <= qlo + 31) {
            f32x16 p0, p1; bf16x8 pa0, pa1, pa2, pa3; float alpha;
            qkt_b<false>(p0, p1, (unsigned)(size_t)(lds + bf * 4 * TILE + mp * TILE), r32, hi, qr);
            if (kb + 63 > qlo) mask_incl(p0, p1, qm - kb);
            if constexpr (FIXED) { constexpr float C2f = LOG2E * SCALE; alpha = 1.f;
#pragma unroll
                for (int r = 0; r < 16; ++r) { p0[r] = __builtin_amdgcn_exp2f(fmaf(p0[r], C2f, mfix2)); p1[r] = __builtin_amdgcn_exp2f(fmaf(p1[r], C2f, mfix2)); } }
            else {
            partialSM(p0, p1, m_reg, alpha);
            if (__any(alpha < 1.f)) { if (hi == 0) al_l[r32] = alpha; asm volatile("s_waitcnt lgkmcnt(0)" ::: "memory");
#pragma unroll
                for (int r = 0; r < 16; ++r) { const float a = al_l[crow(r, hi)];
#pragma unroll
                    for (int d = 0; d < 8; ++d) o[d][r] *= a; } }
            }
            finishSM(p0, p1, alpha, l_reg, pa0, pa1, pa2, pa3);
            pv_tile2<8>(o, vbase + bf * 4 * TILE + 2 * TILE, pa0, pa1, pa2, pa3);
        }
        VMW(); __syncthreads();
    }
#undef DF_STAGE
    if (hi == 0) li_l[r32] = l_reg; asm volatile("s_waitcnt lgkmcnt(0)" ::: "memory");
    float rli[16];
#pragma unroll
    for (int r = 0; r < 16; ++r) rli[r] = 1.0f / li_l[crow(r, hi)];
    LAS float* xch = (LAS float*)lds + wq * 8192 + lane;
    if (mp == 1) {
#pragma unroll
        for (int d = 0; d < 8; ++d)
#pragma unroll
            for (int r = 0; r < 16; ++r) xch[(d * 16 + r) * 64] = o[d][r] * (rli[r] * lam);
    }
    __syncthreads();
    if (mp == 0) {
        float ssq[16];
#pragma unroll
        for (int r = 0; r < 16; ++r) ssq[r] = 0.f;
#pragma unroll
        for (int d = 0; d < 8; ++d)
#pragma unroll
            for (int r = 0; r < 16; ++r) { const float v = o[d][r] * rli[r] - xch[(d * 16 + r) * 64]; o[d][r] = v; ssq[r] += v * v; }
#pragma unroll
        for (int r = 0; r < 16; ++r) { float s = ssq[r]; s = xsum<1>(s); s = xsum<2>(s); s = xsum<4>(s); s = xsum<8>(s); s = xsum<16>(s);
            ssq[r] = post * __builtin_amdgcn_rsqf(s * (1.0f / 256.0f) + EPS); }
#pragma unroll
        for (int d = 0; d < 8; ++d) { const float g = gsub[d * 32 + r32];
#pragma unroll
            for (int r = 0; r < 16; ++r) *(unsigned short*)(rowsq + (size_t)crow(r, hi) * PITCH + d * 32 + r32) = (unsigned short)cvtpk(o[d][r] * ssq[r] * g, 0.f); }
    }
    __syncthreads();
}
}

#define LAS __attribute__((address_space(3)))
typedef unsigned short bf16;
typedef unsigned v4u __attribute__((ext_vector_type(4)));
typedef float f32x4 __attribute__((ext_vector_type(4)));
constexpr int NWAVES = 8;
constexpr int BATCH = 8, SEQ = 2048, DM = 1024, EW = 2048, N4 = 8192, M = BATCH * SEQ, DEPTH = 4, QKVP = 6144;
constexpr float EPS = 1e-6f;
constexpr size_t MiB = 1u << 20;
constexpr size_t WS_XBUF = 512 * 1024, WS_WIN = 1 * MiB, WS_WOUT = 17 * MiB, WS_XN = 24 * MiB, WS_QKV = 56 * MiB, WS_WOUT2 = 248 * MiB, WS_END = 252 * MiB;
constexpr size_t WS_CNT = 16384, CNT_BANK = 64 * 64 * 4;
constexpr int XL_OFF = 131072 + 2048 + 64;
constexpr int LDS_BYTES = XL_OFF + 4096 + 1024;
constexpr int BARST_OFF = 131072 + 2048;
constexpr size_t CTL_ZERO_BYTES = 16384 + 3 * 16384;
#ifndef MK_MULTI
#define MK_MULTI 0
#endif

__device__ __forceinline__ unsigned f2bf(float f) { unsigned u = __builtin_bit_cast(unsigned, f); return (u + 0x7fffu + ((u >> 16) & 1u)) >> 16; }
__device__ __forceinline__ unsigned pk2(float lo, float hi) { return f2bf(lo) | (f2bf(hi) << 16); }
__device__ __forceinline__ float bflo(unsigned w) { return __uint_as_float(w << 16); }
__device__ __forceinline__ float bfhi(unsigned w) { return __uint_as_float(w & 0xffff0000u); }
__device__ __forceinline__ float wave_sum(float v) {
    v = xsum<1>(v); v = xsum<2>(v); v = xsum<4>(v); v = xsum<8>(v); v = xsum<16>(v); v = xsum<32>(v);
    return v;
}
#define LDS_WAIT() asm volatile("s_waitcnt lgkmcnt(0)" ::: "memory")
struct TrItem { const float* W; bf16* WT; int K, N, k0, n0; bool swz; };
constexpr int TR_I_IN = (DM / 64) * (N4 / 32), TR_I_OUT = (EW / 64) * (DM / 32);
__device__ __forceinline__ TrItem tr_decode(int it, const float* w_in, const float* w_out, bf16* Win_t, bf16* Wout_t, bool swz) {
    TrItem t; int r = it;
    if (r < TR_I_IN) { t.W = w_in; t.WT = Win_t; t.K = DM; t.N = N4; t.swz = swz; } else { r -= TR_I_IN; t.W = w_out; t.WT = Wout_t; t.K = EW; t.N = DM; t.swz = false; }
    const int nblk = t.N / 32; t.k0 = 64 * (r / nblk); t.n0 = 32 * (r % nblk); return t;
}
__device__ __forceinline__ void tr_load(const TrItem& t, int lane, f32x4 (&wv)[8]) {
#pragma unroll
    for (int i = 0; i < 8; ++i) wv[i] = __builtin_nontemporal_load((const f32x4*)(t.W + (size_t)(t.k0 + 8 * i + (lane >> 3)) * t.N + t.n0 + 4 * (lane & 7)));
}
__device__ __forceinline__ void tr_finish(const TrItem& t, LAS float* scr, int lane, const f32x4 (&wv)[8]) {
#pragma unroll
    for (int i = 0; i < 8; ++i) { LAS float* d = scr + (8 * i + (lane >> 3)) * 33 + 4 * (lane & 7); d[0] = wv[i].x; d[1] = wv[i].y; d[2] = wv[i].z; d[3] = wv[i].w; }
    LDS_WAIT(); asm volatile("" ::: "memory");
    const int c = lane & 7;
#pragma unroll
    for (int j = 0; j < 4; ++j) { const int n = (lane >> 3) + 8 * j; const LAS float* s = scr + (8 * c) * 33 + n;
        int nr = t.n0 + n; if (t.swz && nr < 4096) nr = (nr & ~0xC0) | ((nr & 0x40) << 1) | ((nr & 0x80) >> 1);
        v4u o; o.x = pk2(s[0 * 33], s[1 * 33]); o.y = pk2(s[2 * 33], s[3 * 33]); o.z = pk2(s[4 * 33], s[5 * 33]); o.w = pk2(s[6 * 33], s[7 * 33]);
        *(v4u*)(t.WT + (size_t)nr * t.K + t.k0 + 8 * c) = o; }
    LDS_WAIT(); asm volatile("" ::: "memory");
}
__device__ __forceinline__ void convert_weights(const float* w_in, const float* w_out, bf16* Win_t, bf16* Wout_t, bool swz, LAS float* scr, int gw, int NGW, int lane) {
    for (int it = gw; it < TR_I_IN + TR_I_OUT; it += 2 * NGW) {
        const bool two = it + NGW < TR_I_IN + TR_I_OUT;
        const TrItem a = tr_decode(it, w_in, w_out, Win_t, Wout_t, swz), b = tr_decode(two ? it + NGW : it, w_in, w_out, Win_t, Wout_t, swz);
        f32x4 wa[8], wb[8];
        tr_load(a, lane, wa); if (two) tr_load(b, lane, wb);
        tr_finish(a, scr, lane, wa);
        if (two) tr_finish(b, scr, lane, wb);
    }
}
__device__ __forceinline__ void rms_row_to_bf16(const float* xrow, const float* g, bf16* orow, int lane) {
    const f32x4* xr = (const f32x4*)xrow + lane; const f32x4* gr = (const f32x4*)g + lane;
    f32x4 v[4]; float s = 0.f;
#pragma unroll
    for (int j = 0; j < 4; ++j) { v[j] = xr[64 * j]; s += (v[j].x * v[j].x + v[j].y * v[j].y) + (v[j].z * v[j].z + v[j].w * v[j].w); }
    const float rstd = 1.0f / sqrtf(wave_sum(s) * (1.f / DM) + EPS);
    unsigned long long* o8 = (unsigned long long*)orow + lane;
#pragma unroll
    for (int j = 0; j < 4; ++j) { const f32x4 gg = gr[64 * j];
        o8[64 * j] = (unsigned long long)pk2(v[j].x * rstd * gg.x, v[j].y * rstd * gg.y) | ((unsigned long long)pk2(v[j].z * rstd * gg.z, v[j].w * rstd * gg.w) << 32); }
}

#define XB_TMO      128
#define XB_XCNT(j)  (256  + 64 * (j))
#define XB_XSUB(j)  (1280 + 64 * (j))
#define XB_XGEN(j)  (2304 + 64 * (j))
#define XB_TOP      3328
#define XB_TOPGEN   3392
#define XCD_BAR_WORDS 3456
#define XB_SPIN_CAP (1u << 18)

__device__ __forceinline__ unsigned xb_ld(unsigned* p)              { return __hip_atomic_load(p, __ATOMIC_RELAXED, __HIP_MEMORY_SCOPE_AGENT); }
__device__ __forceinline__ unsigned xb_add(unsigned* p, unsigned v) { return __hip_atomic_fetch_add(p, v, __ATOMIC_RELAXED, __HIP_MEMORY_SCOPE_AGENT); }
__device__ __forceinline__ unsigned xb_xcc_id() { return (unsigned)__builtin_amdgcn_s_getreg((3 << 11) | 20) & 0xFu; }
#define XB_SPIN(cond, bar) do { unsigned _sp = 0; while (cond) { __builtin_amdgcn_s_sleep(1); \
    if ((++_sp & 255u) == 0u) { if (xb_ld(&(bar)[XB_TMO])) break; if (_sp > XB_SPIN_CAP) { atomicAdd(&(bar)[XB_TMO], 1u); break; } } } } while (0)

struct XcdBarrier {
    unsigned* bar; unsigned x;
    volatile LAS unsigned* st;
};

__device__ __forceinline__ XcdBarrier xcd_barrier_post(unsigned* bar, volatile LAS unsigned* st) {
    XcdBarrier b; b.bar = bar; b.x = xb_xcc_id(); b.st = st;
    if (threadIdx.x == 0) (void)xb_add(&bar[XB_XCNT(b.x)], 1u);
    return b;
}
__device__ __forceinline__ void xcd_barrier_complete(unsigned* bar, unsigned x, unsigned& nloc, unsigned& nx) {
    const unsigned G = gridDim.x * gridDim.y * gridDim.z;
    unsigned sum, cnt, mine, sp = 0u;
    for (;;) {
        sum = 0u; cnt = 0u; mine = 0u;
#pragma unroll
        for (unsigned j = 0; j < 16; ++j) { const unsigned c = xb_ld(&bar[XB_XCNT(j)]); sum += c; cnt += (c > 0u) ? 1u : 0u; mine = (j == x) ? c : mine; }
        if (sum == G) break;
        __builtin_amdgcn_s_sleep(1);
        if ((++sp & 255u) == 0u) { if (xb_ld(&bar[XB_TMO])) break; if (sp > XB_SPIN_CAP) { atomicAdd(&bar[XB_TMO], 1u); break; } }
    }
    nloc = mine > 0u ? mine : 1u; nx = cnt > 0u ? cnt : 1u;
}

__device__ __forceinline__ void xcd_barrier(const XcdBarrier& b, bool leader) {
    asm volatile("s_waitcnt vmcnt(0)" ::: "memory");
    __syncthreads();
    if (leader) {
        unsigned* bar = b.bar;
        __builtin_amdgcn_s_waitcnt(0);
        unsigned nloc = b.st[0], nx = b.st[1];
        if (nloc == 0u) { xcd_barrier_complete(bar, b.x, nloc, nx); b.st[0] = nloc; b.st[1] = nx; }
        const unsigned old = xb_add(&bar[XB_XSUB(b.x)], 1u);
        const unsigned gen = old / nloc;
        if (old + 1u == (gen + 1u) * nloc) {
            __builtin_amdgcn_fence(__ATOMIC_RELEASE, "agent");
            asm volatile("s_waitcnt vmcnt(0)" ::: "memory");
            const unsigned og = xb_add(&bar[XB_TOP], 1u);
            const unsigned tg = og / nx;
            if (og + 1u == (tg + 1u) * nx) xb_add(&bar[XB_TOPGEN], 1u);
            else XB_SPIN(xb_ld(&bar[XB_TOPGEN]) == tg, bar);
            __builtin_amdgcn_fence(__ATOMIC_ACQUIRE, "agent");
            xb_add(&bar[XB_XGEN(b.x)], 1u);
            asm volatile("s_waitcnt vmcnt(0)" ::: "memory");
        } else {
            XB_SPIN(xb_ld(&bar[XB_XGEN(b.x)]) == gen, bar);
            __builtin_amdgcn_fence(__ATOMIC_ACQUIRE, "agent");
            asm volatile("s_waitcnt vmcnt(0)" ::: "memory");
        }
    }
    __syncthreads();
}

struct Params { const float* in[14]; float* out; unsigned char* ws; int ph_lo, ph_hi, probe, pad; };
#ifndef PROBE
#define PROBE 0
#endif

__global__ void __launch_bounds__(NWAVES * 64, 2) fwd(Params p) {
    extern __shared__ __attribute__((aligned(16))) unsigned char lds_raw[];
    LAS unsigned char* lds = (LAS unsigned char*)lds_raw;
    cg::grid_group grid = cg::this_grid();
    const int wave0 = __builtin_amdgcn_readfirstlane((int)threadIdx.x >> 6);
    if (threadIdx.x < 16) ((LAS unsigned*)(lds + BARST_OFF))[threadIdx.x] = 0u;
    __syncthreads();
    XcdBarrier bar = xcd_barrier_post((unsigned*)p.ws, (volatile LAS unsigned*)(lds + BARST_OFF));
    if (p.ph_lo < 0) grid.sync();
    const int G = gridDim.x, NGW = G * NWAVES;
    unsigned char* ws = p.ws;
    bf16* Win_t = (bf16*)(ws + WS_WIN); bf16* XN = (bf16*)(ws + WS_XN); bf16* QKV = (bf16*)(ws + WS_QKV);
    const float* x = p.in[0];
    float* out = p.out;

    for (int id = p.ph_lo; id < p.ph_hi; ++id) {
        const int L = id / 6, k = id % 6, j = L >> 1; const bool df = (L & 1) != 0;
        const bool fusedn = (G == 256);
        if (k == 2 || (k == 0 && L > 0 && fusedn)) continue;
        if (id > p.ph_lo) xcd_barrier(bar, my_tid(wave0) == 0);
#define PHASE_IDS() int tid_o = my_tid(wave0); asm volatile("" : "+v"(tid_o)); const int tid = tid_o, lane = tid & 63, wave = __builtin_amdgcn_readfirstlane(tid >> 6), gw = blockIdx.x * NWAVES + wave; (void)tid; (void)lane; (void)gw
        const float* nrm = (df ? p.in[4] : p.in[1]) + (size_t)j * DM;
        const float* w_in = (df ? p.in[5] : p.in[2]) + (size_t)j * DM * N4;
        const float* w_out = (df ? p.in[6] : p.in[3]) + (size_t)j * EW * DM;
        const float* hin = (L == 0) ? x : out;
        bf16* Wout_t = (bf16*)(ws + ((L & 1) ? WS_WOUT2 : WS_WOUT));
        if (k == 0) {
            PHASE_IDS();
            LAS float* scr = (LAS float*)(lds + wave * 16384);
            convert_weights(w_in, w_out, Win_t, Wout_t, df, scr, gw, NGW, lane);
            for (int m = gw; m < M; m += 2 * NGW) {
                const int m2 = m + NGW; const bool two = m2 < M;
                const f32x4* xa = (const f32x4*)(hin + (size_t)m * DM) + lane; const f32x4* xb = (const f32x4*)(hin + (size_t)(two ? m2 : m) * DM) + lane; const f32x4* gr = (const f32x4*)nrm + lane;
                f32x4 va[4], vb[4]; float sa = 0.f, sb = 0.f;
#pragma unroll
                for (int jj = 0; jj < 4; ++jj) { va[jj] = xa[64 * jj]; vb[jj] = xb[64 * jj]; }
#pragma unroll
                for (int jj = 0; jj < 4; ++jj) { sa += (va[jj].x * va[jj].x + va[jj].y * va[jj].y) + (va[jj].z * va[jj].z + va[jj].w * va[jj].w); sb += (vb[jj].x * vb[jj].x + vb[jj].y * vb[jj].y) + (vb[jj].z * vb[jj].z + vb[jj].w * vb[jj].w); }
                const float ra = 1.0f / sqrtf(wave_sum(sa) * (1.f / DM) + EPS), rb = 1.0f / sqrtf(wave_sum(sb) * (1.f / DM) + EPS);
                unsigned long long* oa = (unsigned long long*)(XN + (size_t)m * DM) + lane; unsigned long long* ob = (unsigned long long*)(XN + (size_t)m2 * DM) + lane;
#pragma unroll
                for (int jj = 0; jj < 4; ++jj) { const f32x4 gg = gr[64 * jj];
                    oa[64 * jj] = (unsigned long long)pk2(va[jj].x * ra * gg.x, va[jj].y * ra * gg.y) | ((unsigned long long)pk2(va[jj].z * ra * gg.z, va[jj].w * ra * gg.w) << 32);
                    if (two) ob[64 * jj] = (unsigned long long)pk2(vb[jj].x * rb * gg.x, vb[jj].y * rb * gg.y) | ((unsigned long long)pk2(vb[jj].z * rb * gg.z, vb[jj].w * rb * gg.w) << 32); }
            }
        } else if (k == 1) {
            pg8::Gemm g{XN, Win_t, M, QKVP, DM, DM, wave0}; pg8::StaticOrder S; S.init(M, QKVP, G, (int)blockIdx.x);
            PHASE_IDS();
            LAS float* xl = (LAS float*)(lds + XL_OFF);
            if (df) { if (tid < 256) xl[1024 + tid] = (tid < 128 ? p.in[7] + (size_t)j * 128 : p.in[8] + (size_t)j * 128 - 128)[tid]; __syncthreads(); }
            pg8::EpiStoreBf16 E{QKV, QKVP, df ? 1 : 0, xl};
            pg8::gemm_phase<pg8::EpiStoreBf16, pg8::StaticOrder, true, true>(lds, g, S, E);
        } else if (k == 3) {
            PHASE_IDS();
            LAS char* al = (LAS char*)lds;
            if (!df) {
                for (int jb = blockIdx.x; jb < 256; jb += G) { const int job = ((jb & 7) << 5) | (jb >> 3); const int bh = job >> 1, st = job & 1;
#pragma unroll 1
                    for (int u = 0; u < 4; ++u) { const int base = st ? 2 : 0; const int qb = (u & 1) ? base + (u >> 1) : 7 - base - (u >> 1);
                        att::sb_unit(al, QKV, bh >> 4, bh & 15, qb, wave0); } }
            } else {
                const float* lq1 = p.in[9] + (size_t)j * 128; const float* lk1 = p.in[10] + (size_t)j * 128; const float* lq2 = p.in[11] + (size_t)j * 128; const float* lk2 = p.in[12] + (size_t)j * 128;
                const float lam_init = 0.8f - 0.6f * expf(-0.3f * (float)L);
                const float s1 = wave_sum(lq1[lane] * lk1[lane] + lq1[lane + 64] * lk1[lane + 64]), s2 = wave_sum(lq2[lane] * lk2[lane] + lq2[lane + 64] * lk2[lane + 64]);
                const float lam = __uint_as_float(__builtin_amdgcn_readfirstlane(__float_as_uint(expf(s1) - expf(s2) + lam_init)));
                const float* gsub = p.in[13] + (size_t)j * 256;
                float mfix2 = 0.f; bool fixedref = false;
                { const float* gq = p.in[7] + (size_t)j * 128; const float* gk = p.in[8] + (size_t)j * 128;
                  float mq = fmaxf(fabsf(gq[lane]), fabsf(gq[lane + 64])), mk = fmaxf(fabsf(gk[lane]), fabsf(gk[lane + 64]));
#define WMAX_(v, m_) v = fmaxf(v, __int_as_float(__builtin_amdgcn_ds_swizzle(__float_as_int(v), ((m_) << 10) | 0x1F)))
                  WMAX_(mq, 1); WMAX_(mq, 2); WMAX_(mq, 4); WMAX_(mq, 8); WMAX_(mq, 16); WMAX_(mk, 1); WMAX_(mk, 2); WMAX_(mk, 4); WMAX_(mk, 8); WMAX_(mk, 16);
#undef WMAX_
                  { auto r1 = __builtin_amdgcn_permlane32_swap(__float_as_uint(mq), __float_as_uint(mq), false, false); mq = fmaxf(__uint_as_float(r1[0]), __uint_as_float(r1[1]));
                    auto r2 = __builtin_amdgcn_permlane32_swap(__float_as_uint(mk), __float_as_uint(mk), false, false); mk = fmaxf(__uint_as_float(r2[0]), __uint_as_float(r2[1])); }
                  const float bound = __uint_as_float(__builtin_amdgcn_readfirstlane(__float_as_uint(11.313708499f * mq * mk * 1.01f + 0.1f)));
                  fixedref = bound <= 40.0f; mfix2 = -bound * 1.4426950408889634f; }
                for (int jb = blockIdx.x; jb < 256; jb += G) { const int job = ((jb & 7) << 5) | (jb >> 3); const int bh = job >> 2, st = job & 3;
#pragma unroll 1
                    for (int u = 0; u < 4; ++u) { const int qb = (u == 0) ? 15 - st : (u == 1) ? st : (u == 2) ? 8 + st : 7 - st;
                        if (fixedref) att::df_unit<true>(al, QKV, gsub, lam, 1.0f - lam_init, bh >> 3, bh & 7, qb, wave0, mfix2);
                        else att::df_unit<false>(al, QKV, gsub, lam, 1.0f - lam_init, bh >> 3, bh & 7, qb, wave0, 0.f); } }
            }
        } else if (k == 4) {
            pg8::Gemm g{XN, Win_t + (size_t)QKVP * DM, M, EW, DM, DM, wave0}; pg8::StaticOrder S; S.init(M, EW, G, (int)blockIdx.x);
            pg8::EpiGate E{QKV, QKVP};
            pg8::gemm_phase<pg8::EpiGate, pg8::StaticOrder, true, true>(lds, g, S, E);
        } else {
            pg8::Gemm g{QKV, Wout_t, M, DM, EW, QKVP, wave0}; pg8::StaticOrder S; S.init(M, DM, G, (int)blockIdx.x);
            if (fusedn && L + 1 < DEPTH) {
                const int Ln = L + 1, jn = Ln >> 1; const bool dfn = (Ln & 1) != 0;
                const float* nrm_n = (dfn ? p.in[4] : p.in[1]) + (size_t)jn * DM;
                pg8::RowStats st{(unsigned*)(ws + WS_XBUF), (unsigned*)(ws + WS_CNT + (size_t)L * CNT_BANK)};
                pg8::EpiResNorm E{hin, out, DM, XN, nrm_n, st};
                pg8::gemm_phase<pg8::EpiResNorm, pg8::StaticOrder, false, true>(lds, g, S, E);
                __syncthreads();
                PHASE_IDS();
                const float* w_in_n = (dfn ? p.in[5] : p.in[2]) + (size_t)jn * DM * N4;
                const float* w_out_n = (dfn ? p.in[6] : p.in[3]) + (size_t)jn * EW * DM;
                bf16* Wout_n = (bf16*)(ws + ((Ln & 1) ? WS_WOUT2 : WS_WOUT));
                LAS float* scr = (LAS float*)(lds + wave * 16384);
                convert_weights(w_in_n, w_out_n, Win_t, Wout_n, dfn, scr, gw, NGW, lane);
            } else {
                pg8::EpiResidual E{hin, out, DM};
                pg8::gemm_phase<pg8::EpiResidual, pg8::StaticOrder, true, true>(lds, g, S, E);
            }
        }
    }
}

extern "C" void kernel_launch(void* const* d_in, const int* in_sizes, int n_in, void* d_out, int out_size, void* d_ws, size_t ws_size, hipStream_t stream) {
    static int grid = 0;
    if (grid == 0) {
        if (n_in != 14 || in_sizes[0] != M * DM || out_size != M * DM || ws_size < WS_END) { fprintf(stderr, "kernel_launch: unexpected shapes (n_in %d in0 %d out %d ws %zu)\n", n_in, n_in > 0 ? in_sizes[0] : -1, out_size, ws_size); grid = -1; return; }
        int dev = 0, cus = 0, per_cu = 0;
        (void)hipGetDevice(&dev); (void)hipDeviceGetAttribute(&cus, hipDeviceAttributeMultiprocessorCount, dev);
        if (hipFuncSetAttribute((const void*)fwd, hipFuncAttributeMaxDynamicSharedMemorySize, LDS_BYTES) != hipSuccess) { fprintf(stderr, "kernel_launch: hipFuncSetAttribute failed\n"); grid = -1; return; }
        if (hipOccupancyMaxActiveBlocksPerMultiprocessor(&per_cu, (const void*)fwd, NWAVES * 64, LDS_BYTES) != hipSuccess || per_cu < 1) { fprintf(stderr, "kernel_launch: occupancy query gave %d\n", per_cu); per_cu = 1; }
        (void)hipGetLastError();
        if (cus <= 0) cus = 256;
        grid = cus * per_cu; if (grid > 256) grid = 256;
    }
    if (grid < 0) return;
    if (hipMemsetAsync(d_ws, 0, CTL_ZERO_BYTES, stream) != hipSuccess) { fprintf(stderr, "kernel_launch: memset failed\n"); return; }
    Params p{};
    for (int i = 0; i < 14; ++i) p.in[i] = (const float*)d_in[i];
    p.out = (float*)d_out; p.ws = (unsigned char*)d_ws; p.probe = PROBE;
#if MK_MULTI
    for (int id = 0; id < DEPTH * 6; ++id) { if ((id % 6) == 2 && ((id / 6) & 1) == 0) continue;
        p.ph_lo = id; p.ph_hi = id + 1; void* args[] = {&p};
        hipError_t e = hipLaunchCooperativeKernel((const void*)fwd, dim3(grid), dim3(NWAVES * 64), args, LDS_BYTES, stream);
        if (e != hipSuccess) { fprintf(stderr, "launch %d failed: %s\n", id, hipGetErrorString(e)); break; } }
#else
    p.ph_lo = 0; p.ph_hi = DEPTH * 6; void* args[] = {&p};
    hipError_t e = hipLaunchCooperativeKernel((const void*)fwd, dim3(grid), dim3(NWAVES * 64), args, LDS_BYTES, stream);
    if (e != hipSuccess) fprintf(stderr, "cooperative launch failed: %s (grid %d)\n", hipGetErrorString(e), grid);
#endif
}
```
